# Optimizing an MI355X kernel written in HIP

```python
import jax, jax.numpy as jnp
from jax import lax
import numpy as np

D_MODEL = 1024
BATCH = 16
SEQ = 4096
DEPTH = 1

CONV_WIDTH = 512
CONV_K = 3
N_HEADS = 8
HEAD_DIM = 64
ATTN_WIDTH = N_HEADS * HEAD_DIM
Q_BLOCK = 128
N_GROUPS = 4
EXPERTS_PER_GROUP = 8
N_EXPERTS = N_GROUPS * EXPERTS_PER_GROUP
TOP_K_IN_GROUP = 2
D_EXPERT = 256
EPS = 1e-6
IN_COLS = 3 * CONV_WIDTH + 3 * ATTN_WIDTH + N_HEADS + 2 * D_MODEL

kernel_name = "hybrid_shortconv_fox_hmoe_block"


def rmsnorm(x, w):
    xf = x.astype(jnp.float32)
    y = xf * lax.rsqrt(jnp.mean(xf * xf, axis=-1, keepdims=True) + EPS)
    return (y * w.astype(jnp.float32)).astype(x.dtype)


def modulate(x, norm_w, shift, scale):
    return rmsnorm(x, norm_w) * (1 + scale[:, None, :]) + shift[:, None, :]


def causal_depthwise_conv(u, w):
    S = u.shape[1]
    up = jnp.pad(u, ((0, 0), (CONV_K - 1, 0), (0, 0)))
    out = w[0] * up[:, 0:S]
    for j in range(1, CONV_K):
        out = out + w[j] * up[:, j:j + S]
    return out


def forgetting_attention(q, k, v, log_f):
    B, H, S, Dh = q.shape
    nblk = S // Q_BLOCK
    F = jnp.cumsum(log_f, axis=-1)
    scale = HEAD_DIM ** -0.5
    k_pos = jnp.arange(S)
    q_blocks = q.reshape(B, H, nblk, Q_BLOCK, Dh).transpose(2, 0, 1, 3, 4)
    F_blocks = F.reshape(B, H, nblk, Q_BLOCK).transpose(2, 0, 1, 3)

    def one_block(args):
        i, q_i, F_i = args
        s = jnp.einsum('bhqd,bhkd->bhqk', q_i, k,
                       preferred_element_type=jnp.float32) * scale
        s = s + (F_i[..., :, None] - F[..., None, :])
        q_pos = i * Q_BLOCK + jnp.arange(Q_BLOCK)
        s = jnp.where(k_pos[None, :] <= q_pos[:, None], s, -jnp.inf)
        p = jax.nn.softmax(s, axis=-1)
        return jnp.einsum('bhqk,bhkd->bhqd', p.astype(v.dtype), v)

    o = lax.map(one_block, (jnp.arange(nblk), q_blocks, F_blocks))
    return o.transpose(1, 0, 3, 2, 4).reshape(B, S, H * Dh)


def hierarchical_moe(h, w_rg, b_rg, w_re, b_re, w_gate, w_up, w_down):
    B, S, _ = h.shape
    lg = (h @ w_rg).astype(jnp.float32) + b_rg.astype(jnp.float32)
    p_g = jax.nn.softmax(lg, axis=-1)
    g_idx = jnp.argmax(lg, axis=-1)
    p_sel = jnp.take_along_axis(p_g, g_idx[..., None], axis=-1)
    le = ((h @ w_re).astype(jnp.float32) + b_re.astype(jnp.float32)
          ).reshape(B, S, N_GROUPS, EXPERTS_PER_GROUP)
    le_g = jnp.take_along_axis(le, g_idx[..., None, None], axis=2)[:, :, 0]
    top_v, top_i = lax.top_k(le_g, TOP_K_IN_GROUP)
    w_k = jax.nn.softmax(top_v, axis=-1) * p_sel
    e_idx = g_idx[..., None] * EXPERTS_PER_GROUP + top_i
    comb = jnp.sum(jax.nn.one_hot(e_idx, N_EXPERTS, dtype=jnp.float32)
                   * w_k[..., None], axis=-2).astype(h.dtype)
    out = jnp.zeros_like(h)
    for e in range(N_EXPERTS):
        a = jax.nn.silu(h @ w_gate[e]) * (h @ w_up[e])
        out = out + comb[..., e:e + 1] * (a @ w_down[e])
    return out


def hybrid_layer(x, c, w_ada, b_ada, norm1_w, w_in, b_forget, conv_w,
                 q_norm_w, k_norm_w, w_out_conv, w_out_attn, w_o, norm2_w,
                 w_router_group, b_router_group, w_router_expert, b_router_expert,
                 w_gate, w_up, w_down):
    B, S, _ = x.shape
    mod = jax.nn.silu(c) @ w_ada + b_ada
    shift1, scale1, gate1, shift2, scale2, gate2 = jnp.split(mod, 6, axis=-1)

    h = modulate(x, norm1_w, shift1, scale1)
    proj = h @ w_in
    sizes = [CONV_WIDTH, CONV_WIDTH, CONV_WIDTH, ATTN_WIDTH, ATTN_WIDTH,
             ATTN_WIDTH, N_HEADS, D_MODEL]
    cuts = [int(v) for v in np.cumsum(sizes)]
    x_in, conv_b, conv_c, q, k, v, f_logit, gate_conv_l, gate_attn_l = jnp.split(
        proj, cuts, axis=-1)

    y_a = conv_b * causal_depthwise_conv(conv_c * x_in, conv_w)
    p_a = y_a @ w_out_conv

    q = rmsnorm(q.reshape(B, S, N_HEADS, HEAD_DIM), q_norm_w).transpose(0, 2, 1, 3)
    k = rmsnorm(k.reshape(B, S, N_HEADS, HEAD_DIM), k_norm_w).transpose(0, 2, 1, 3)
    v = v.reshape(B, S, N_HEADS, HEAD_DIM).transpose(0, 2, 1, 3)
    log_f = jax.nn.log_sigmoid((f_logit + b_forget).astype(jnp.float32)).transpose(0, 2, 1)
    y_b = forgetting_attention(q, k, v, log_f)
    p_b = y_b @ w_out_attn

    merged = jax.nn.sigmoid(gate_conv_l) * p_a + jax.nn.sigmoid(gate_attn_l) * p_b
    x = x + gate1[:, None, :] * (merged @ w_o)

    h2 = modulate(x, norm2_w, shift2, scale2)
    moe = hierarchical_moe(h2, w_router_group, b_router_group, w_router_expert,
                           b_router_expert, w_gate, w_up, w_down)
    return x + gate2[:, None, :] * moe


def setup_inputs(seed: int = 0) -> dict:
    key = jax.random.key(seed)
    ks = jax.random.split(key, 22)
    f32 = jnp.float32
    L = DEPTH

    def nrm(k, shape, scale):
        return jax.random.normal(k, shape, f32) * scale

    return {
        "x": nrm(ks[0], (BATCH, SEQ, D_MODEL), 1.0),
        "c": nrm(ks[1], (BATCH, D_MODEL), 1.0),
        "w_ada": nrm(ks[2], (L, D_MODEL, 6 * D_MODEL), 0.5 * D_MODEL ** -0.5),
        "b_ada": nrm(ks[3], (L, 6 * D_MODEL), 0.02),
        "norm1_w": 1.0 + nrm(ks[4], (L, D_MODEL), 0.02),
        "w_in": nrm(ks[5], (L, D_MODEL, IN_COLS), D_MODEL ** -0.5),
        "b_forget": 4.0 + nrm(ks[6], (L, N_HEADS), 0.5),
        "conv_w": nrm(ks[7], (L, CONV_K, CONV_WIDTH), CONV_K ** -0.5),
        "q_norm_w": 1.0 + nrm(ks[8], (L, HEAD_DIM), 0.02),
        "k_norm_w": 1.0 + nrm(ks[9], (L, HEAD_DIM), 0.02),
        "w_out_conv": nrm(ks[10], (L, CONV_WIDTH, D_MODEL), CONV_WIDTH ** -0.5),
        "w_out_attn": nrm(ks[11], (L, ATTN_WIDTH, D_MODEL), ATTN_WIDTH ** -0.5),
        "w_o": nrm(ks[12], (L, D_MODEL, D_MODEL), D_MODEL ** -0.5),
        "norm2_w": 1.0 + nrm(ks[13], (L, D_MODEL), 0.02),
        "w_router_group": nrm(ks[14], (L, D_MODEL, N_GROUPS), D_MODEL ** -0.5),
        "b_router_group": nrm(ks[15], (L, N_GROUPS), 0.01),
        "w_router_expert": nrm(ks[16], (L, D_MODEL, N_EXPERTS), D_MODEL ** -0.5),
        "b_router_expert": nrm(ks[17], (L, N_EXPERTS), 0.01),
        "w_gate": nrm(ks[18], (L, N_EXPERTS, D_MODEL, D_EXPERT), D_MODEL ** -0.5),
        "w_up": nrm(ks[19], (L, N_EXPERTS, D_MODEL, D_EXPERT), D_MODEL ** -0.5),
        "w_down": nrm(ks[20], (L, N_EXPERTS, D_EXPERT, D_MODEL), D_EXPERT ** -0.5),
    }


def reference(x, c, w_ada, b_ada, norm1_w, w_in, b_forget, conv_w, q_norm_w,
              k_norm_w, w_out_conv, w_out_attn, w_o, norm2_w, w_router_group,
              b_router_group, w_router_expert, b_router_expert, w_gate, w_up,
              w_down):
    for l in range(DEPTH):
        x = hybrid_layer(x, c, w_ada[l], b_ada[l], norm1_w[l], w_in[l], b_forget[l],
                         conv_w[l], q_norm_w[l], k_norm_w[l], w_out_conv[l],
                         w_out_attn[l], w_o[l], norm2_w[l], w_router_group[l],
                         b_router_group[l], w_router_expert[l], b_router_expert[l],
                         w_gate[l], w_up[l], w_down[l])
    return x
```

```cpp
#include <hip/hip_runtime.h>
#include <cstdio>
#include <cstdint>
__device__ __forceinline__ int mk_lane() { int l; asm volatile("v_mbcnt_lo_u32_b32 %0, -1, 0\n\tv_mbcnt_hi_u32_b32 %0, -1, %0" : "=v"(l)); return l; }
#define MK_N_LAUNCHES 1
namespace pg8 {
#define PG8_LAS __attribute__((address_space(3)))
typedef unsigned short bf16_t;
typedef short bf16x8 __attribute__((ext_vector_type(8)));
typedef float f32x4 __attribute__((ext_vector_type(4)));
typedef unsigned u32x4 __attribute__((ext_vector_type(4)));
typedef int v4i_t __attribute__((ext_vector_type(4)));
typedef int v8i_t __attribute__((ext_vector_type(8)));
constexpr int BM = 256, BK = 64, HALF = 128, HTB = HALF * BK * 2  , STAGE_BYTES = 8 * HTB, NXCD = 8, WGM = 8;
constexpr int RAW_LDS_OFF = 161792;
constexpr int NA_LDS_OFF = 137216;

__host__ __device__ __forceinline__ int lds_byte(int r, int c) { const int st = (r >> 4) * 2 + (c >> 5), rr = r & 15, cc = c & 31, ob = rr * 64 + cc * 2; return st * 1024 + (ob ^ (((ob >> 9) & 1) << 5)); }
__host__ __device__ __forceinline__ void stage_rc(int b, int& R, int& C) { const int st = b / 1024, sb = b % 1024, swz = sb ^ (((sb >> 9) & 1) << 5); R = (st >> 1) * 16 + swz / 64; C = (st & 1) * 32 + (swz % 64) / 2; }
__host__ __device__ __forceinline__ int perm32(int rho) { const int n = rho >> 4, i = rho & 15; return 8 * (i >> 2) + 4 * n + (i & 3); }

struct Unit { int pm, pn, e, lt, cnt; };

struct StaticOrderCore {
    int nM, nN, nwg, G, c;
    __device__ __forceinline__ void init(int M, int N, int G_, int c_) { nM = M / BM; nN = N / BM; nwg = nM * nN; G = G_; c = c_; }
    __device__ __forceinline__ bool next(int i, Unit& u) const {
        const long L = (long)i * G + c; if (L >= nwg) return false;
        int wgid = (int)L; { const int q = nwg / NXCD, r = nwg % NXCD, xcd = wgid % NXCD, off = wgid / NXCD; wgid = (xcd < r ? xcd * (q + 1) : r * (q + 1) + (xcd - r) * q) + off; }
        const int nig = WGM * nN, gid = wgid / nig, fm = gid * WGM, gsz = (nM - fm) < WGM ? (nM - fm) : WGM;
        u.pm = __builtin_amdgcn_readfirstlane(fm + ((wgid % nig) % gsz)); u.pn = __builtin_amdgcn_readfirstlane((wgid % nig) / gsz); u.e = 0; u.lt = 0; u.cnt = 0; return true;
    }
};
struct DenseStatic {
    const char* A; const char* Bt; size_t a_tstep, b_tstep; StaticOrderCore so;
    __device__ __forceinline__ bool next(int i, Unit& u) const { return so.next(i, u); }
    __device__ __forceinline__ const char* a_base(const Unit& u) const { return A + (size_t)u.pm * a_tstep; }
    __device__ __forceinline__ const char* b_base(const Unit& u) const { return Bt + (size_t)u.pn * b_tstep; }
    __device__ __forceinline__ int row_index(const Unit&, int) const { return 0; }
};
struct OwnPanel {
    const char* A; const char* Bt; size_t a_tstep, b_tstep; int panel, nN;
    __device__ __forceinline__ bool next(int i, Unit& u) const { if (i >= nN) return false; u.pm = __builtin_amdgcn_readfirstlane(panel); u.pn = i; u.e = 0; u.lt = 0; u.cnt = 0; return true; }
    __device__ __forceinline__ const char* a_base(const Unit& u) const { return A + (size_t)u.pm * a_tstep; }
    __device__ __forceinline__ const char* b_base(const Unit& u) const { return Bt + (size_t)u.pn * b_tstep; }
    __device__ __forceinline__ int row_index(const Unit&, int) const { return 0; }
};

__device__ __forceinline__ unsigned cvt_pk_bf16(float lo, float hi) { unsigned r; asm volatile("v_cvt_pk_bf16_f32 %0, %1, %2" : "=v"(r) : "v"(lo), "v"(hi)); return r; }
__device__ __forceinline__ float bf_lo(unsigned w) { return __uint_as_float(w << 16); }
__device__ __forceinline__ float bf_hi(unsigned w) { return __uint_as_float(w & 0xffff0000u); }
__device__ __forceinline__ float sigmoid_f(float x) { return __builtin_amdgcn_rcpf(1.0f + __builtin_amdgcn_exp2f(-1.4426950408889634f * x)); }

__device__ __forceinline__ void glds16_s(const void* sbase, unsigned voff, unsigned lds_dst) {
    unsigned keep;
    asm volatile("s_mov_b32 %0, m0\n\ts_mov_b32 m0, %3\n\ts_nop 0\n\tglobal_load_lds_dwordx4 %1, %2\n\ts_mov_b32 m0, %0" : "=&s"(keep) : "v"(voff), "s"(sbase), "s"(lds_dst) : "memory");
}
__device__ __forceinline__ void glds4_s(const void* sbase, unsigned voff, unsigned lds_dst) {
    unsigned keep;
    asm volatile("s_mov_b32 %0, m0\n\ts_mov_b32 m0, %3\n\ts_nop 0\n\tglobal_load_lds_dword %1, %2\n\ts_mov_b32 m0, %0" : "=&s"(keep) : "v"(voff), "s"(sbase), "s"(lds_dst) : "memory");
}
template <class Epi, class Sched, bool GATHER, bool ALIGN_EPI, bool FP8 = false, bool I8 = false, bool HALFN = false>
__device__ __forceinline__ void gemm_phase(PG8_LAS unsigned char* lds, const int wave, const int lda_e, const int K_e, const Sched& S, const Epi& E) {
    const int lda = (FP8 || I8) ? lda_e / 2 : lda_e, K = (FP8 || I8) ? K_e / 2 : K_e;
    const int lane = mk_lane(), wid = wave, tid = wid * 64 + lane, wr = wid >> 2, wc = wid & 3, fr = lane & 15, fq = lane >> 4;
    const int nt = K / BK;
    static_assert(!(HALFN && Epi::NVM > 0), "HALFN counts its own waits");
    int Rr[2], Cc[2];
    unsigned voffB[2], va0[2], va1[2];
#pragma unroll
    for (int i = 0; i < 2; ++i) { stage_rc(tid * 16 + i * 8192, Rr[i], Cc[i]); const int Rb = Epi::PERM ? ((Rr[i] & ~31) + perm32(Rr[i] & 31)) : Rr[i];
        voffB[i] = (unsigned)(Rb * K + Cc[i]) * 2u; va0[i] = (unsigned)(Rr[i] * lda + Cc[i]) * 2u; va1[i] = va0[i] + (unsigned)(HALF * lda) * 2u; }
    const size_t kstep = (size_t)(BK * 2);
    const size_t hstepB = (size_t)HALF * K * 2;
    const unsigned ldsb = (unsigned)(__SIZE_TYPE__)lds + (unsigned)wid * 1024u;
    const int aoff = lds_byte(wr * 64 + fr, fq * 8), boff = lds_byte(wc * 32 + fr, fq * 8);
#define PG8_SA(b, h) (((b) * 2 + (h)) * HTB)
#define PG8_SB(b, h) ((4 + (b) * 2 + (h)) * HTB)
#define PG8_STAGE2(bufoff, gbase, o0, o1) do { glds16_s((gbase), (o0), ldsb + (unsigned)(bufoff)); glds16_s((gbase), (o1), ldsb + (unsigned)(bufoff) + 8192u); } while (0)
#define PG8_LD8(p) __builtin_shufflevector(*(const PG8_LAS v4i_t*)(p), *(const PG8_LAS v4i_t*)((p) + 1024), 0, 1, 2, 3, 4, 5, 6, 7)
#define PG8_LDA(dst, b, h) do { _Pragma("unroll") for (int m = 0; m < 4; ++m) { if constexpr (FP8) dst##8[m] = PG8_LD8(lds + PG8_SA(b, h) + aoff + m * 2048); else { _Pragma("unroll") for (int k = 0; k < 2; ++k) dst[m][k] = *(const PG8_LAS bf16x8*)(lds + PG8_SA(b, h) + aoff + m * 2048 + k * 1024); } } } while (0)
#define PG8_LDB(dst, b, h) do { _Pragma("unroll") for (int n = 0; n < 2; ++n) { if constexpr (FP8) dst##8[n] = PG8_LD8(lds + PG8_SB(b, h) + boff + n * 2048); else { _Pragma("unroll") for (int k = 0; k < 2; ++k) dst[n][k] = *(const PG8_LAS bf16x8*)(lds + PG8_SB(b, h) + boff + n * 2048 + k * 1024); } } } while (0)
#define PG8_MMA(ai, bj, At, Bt) do { __builtin_amdgcn_s_setprio(1); _Pragma("unroll") for (int m = 0; m < 4; ++m) _Pragma("unroll") for (int n = 0; n < 2; ++n) { \
        if constexpr (FP8) acc[ai][bj][m][n] = __builtin_amdgcn_mfma_scale_f32_16x16x128_f8f6f4(Bt##8[n], At##8[m], acc[ai][bj][m][n], 0, 0, 0, 0x7f7f7f7f, 0, 0x7f7f7f7f); \
        else if constexpr (I8) { _Pragma("unroll") for (int k = 0; k < 2; ++k) acc[ai][bj][m][n] = __builtin_bit_cast(f32x4, __builtin_amdgcn_mfma_i32_16x16x64_i8(__builtin_bit_cast(v4i_t, Bt[n][k]), __builtin_bit_cast(v4i_t, At[m][k]), __builtin_bit_cast(v4i_t, acc[ai][bj][m][n]), 0, 0, 0)); } \
        else { _Pragma("unroll") for (int k = 0; k < 2; ++k) acc[ai][bj][m][n] = __builtin_amdgcn_mfma_f32_16x16x32_bf16(Bt[n][k], At[m][k], acc[ai][bj][m][n], 0, 0, 0); } } __builtin_amdgcn_s_setprio(0); } while (0)
#define PG8_WAIT_V(n) asm volatile("s_waitcnt vmcnt(" #n ")" ::: "memory")
#define PG8_WAIT_K() do { if constexpr (HALFN) PG8_WAIT_V(6); else PG8_WAIT_V(8); } while (0)
#define PG8_STAGE_B1(bufoff, gbase) do { if constexpr (!HALFN) PG8_STAGE2(bufoff, gbase, voffB[0], voffB[1]); } while (0)
#define PG8_WAIT_L(n) asm volatile("s_waitcnt lgkmcnt(" #n ")" ::: "memory")
#define PG8_WAIT_VX(p) do { if (p) asm volatile("s_waitcnt vmcnt(%0)" :: "n"(8 + (Epi::NVM > 0 ? Epi::NVM : 0)) : "memory"); else PG8_WAIT_K(); } while (0)
#define PG8_BAR __builtin_amdgcn_s_barrier()
#define PG8_SCHED __builtin_amdgcn_sched_barrier(0)
    Unit cur, nxt; int ui = 0;
    if (!S.next(0, cur)) return;
#define PG8_VMFLUSH(n) __builtin_amdgcn_s_waitcnt(0x0F70 | ((n) & 15) | (((n) >> 4) << 14))
    PG8_VMFLUSH(0);
    f32x4 acc[2][2][4][2];
#pragma unroll
    for (int a = 0; a < 2; ++a)
#pragma unroll
        for (int b = 0; b < 2; ++b)
#pragma unroll
            for (int m = 0; m < 4; ++m)
#pragma unroll
                for (int n = 0; n < 2; ++n) acc[a][b][m][n] = (f32x4){0.f, 0.f, 0.f, 0.f};
    bf16x8 At[4][2], B0[2][2], B1[2][2]; v8i_t At8[4], B08[2], B18[2];
    const char* cA = S.a_base(cur); const char* cB = S.b_base(cur);
    if constexpr (GATHER) {
#pragma unroll
        for (int i = 0; i < 2; ++i) { va0[i] = ((unsigned)S.row_index(cur, Rr[i]) * (unsigned)lda + (unsigned)Cc[i]) * 2u; va1[i] = ((unsigned)S.row_index(cur, HALF + Rr[i]) * (unsigned)lda + (unsigned)Cc[i]) * 2u; }
    }
    PG8_STAGE2(PG8_SB(0, 0), cB, voffB[0], voffB[1]); PG8_STAGE_B1(PG8_SB(0, 1), cB + hstepB); PG8_STAGE2(PG8_SA(0, 0), cA, va0[0], va0[1]); PG8_STAGE2(PG8_SA(0, 1), cA, va1[0], va1[1]);
    if (wr == 1) PG8_BAR;
    PG8_WAIT_V(2); PG8_BAR;
    PG8_STAGE2(PG8_SB(1, 0), cB + kstep, voffB[0], voffB[1]); PG8_STAGE2(PG8_SA(1, 0), cA + kstep, va0[0], va0[1]); PG8_STAGE_B1(PG8_SB(1, 1), cB + hstepB + kstep);
    if constexpr (HALFN) PG8_WAIT_V(4); else PG8_WAIT_V(6); PG8_BAR;
    for (;;) {
        const bool has_next = S.next(ui + 1, nxt);
        const char* nA = has_next ? S.a_base(nxt) : cA; const char* nB = has_next ? S.b_base(nxt) : cB;
        if constexpr (GATHER) {
            if (has_next && wid < 4) S.ids_dma(nxt, wid * 64 + mk_lane(), (unsigned)(__SIZE_TYPE__)lds + RAW_LDS_OFF + (unsigned)wid * 256u);
        }
        if constexpr (Epi::HAS_PRE) E.pre(cur, ui & 1, wid, mk_lane());
        if constexpr (Epi::HAS_SEG) { const int l_e = mk_lane(); E.seg_fetch(cur, wr, wc, l_e & 15, l_e >> 4); }
#pragma unroll 1
        for (int t = 0; t < nt; t += 2) {
            const bool last = (t == nt - 2);
            const bool pre = Epi::NVM > 0 && t == 0 && ui > 0;
            const char* a1 = cA + (size_t)(t + 1) * kstep;
            const char* a2 = last ? nA : cA + (size_t)(t + 2) * kstep; const char* b2 = last ? nB : cB + (size_t)(t + 2) * kstep;
            const char* a3 = a2 + kstep; const char* b3 = b2 + kstep;
            if constexpr (GATHER) { if (t == 2) {
                const int tid2 = wid * 64 + mk_lane();
                u32x4 nv = (u32x4){va0[0], va0[1], va1[0], va1[1]};
                if (has_next) {
#pragma unroll
                    for (int i = 0; i < 2; ++i) { int R2, C2; stage_rc(tid2 * 16 + i * 8192, R2, C2);
                        const int i0 = *(const PG8_LAS int*)(lds + RAW_LDS_OFF + R2 * 4), i1 = *(const PG8_LAS int*)(lds + RAW_LDS_OFF + (HALF + R2) * 4);
                        nv[i] = ((unsigned)S.row_pick(nxt, R2, i0) * (unsigned)lda + (unsigned)C2) * 2u; nv[2 + i] = ((unsigned)S.row_pick(nxt, HALF + R2, i1) * (unsigned)lda + (unsigned)C2) * 2u; } }
                *(PG8_LAS u32x4*)(lds + NA_LDS_OFF + tid2 * 16) = nv; } }
            if constexpr (Epi::HAS_SEG) { if (t > 0) { const int l_e = mk_lane(), fr_e = l_e & 15, fq_e = l_e >> 4; E.seg(acc, cur, t >> 1, wr, wc, fr_e, fq_e); } }
            if constexpr (Epi::HAS_MID) { if (t == nt / 2) { const int l_e = mk_lane(), fr_e = l_e & 15, fq_e = l_e >> 4; E.mid(acc, cur, wr, wc, fr_e, fq_e); } }
            unsigned x00 = va0[0], x01 = va0[1], x10 = va1[0], x11 = va1[1];
            if constexpr (GATHER) { if (last) { const u32x4 nv = *(const PG8_LAS u32x4*)(lds + NA_LDS_OFF + (wid * 64 + mk_lane()) * 16); x00 = nv[0]; x01 = nv[1]; x10 = nv[2]; x11 = nv[3]; } }
            PG8_LDB(B0, 0, 0); if constexpr (!HALFN) PG8_LDB(B1, 0, 1); PG8_SCHED; PG8_LDA(At, 0, 0); if (!pre) PG8_STAGE2(PG8_SA(1, 1), a1, va1[0], va1[1]);
            PG8_WAIT_VX(pre); PG8_WAIT_L(0); PG8_BAR; PG8_MMA(0, 0, At, B0); if constexpr (!HALFN) PG8_MMA(0, 1, At, B1); PG8_BAR; PG8_SCHED;
            PG8_LDA(At, 0, 1); PG8_STAGE2(PG8_SB(0, 0), b2, voffB[0], voffB[1]); PG8_STAGE_B1(PG8_SB(0, 1), b2 + hstepB); PG8_STAGE2(PG8_SA(0, 0), a2, x00, x01);
            PG8_WAIT_VX(pre); PG8_WAIT_L(0); PG8_BAR; PG8_MMA(1, 0, At, B0); if constexpr (!HALFN) PG8_MMA(1, 1, At, B1); PG8_BAR; PG8_SCHED;
            PG8_LDB(B0, 1, 0); if constexpr (!HALFN) PG8_LDB(B1, 1, 1); PG8_SCHED; PG8_LDA(At, 1, 0); PG8_STAGE2(PG8_SA(0, 1), a2, x10, x11);
            PG8_WAIT_VX(pre); PG8_WAIT_L(0); PG8_BAR; PG8_MMA(0, 0, At, B0); if constexpr (!HALFN) PG8_MMA(0, 1, At, B1); PG8_BAR; PG8_SCHED;
            PG8_LDA(At, 1, 1); PG8_STAGE2(PG8_SB(1, 0), b3, voffB[0], voffB[1]); PG8_STAGE_B1(PG8_SB(1, 1), b3 + hstepB); PG8_STAGE2(PG8_SA(1, 0), a3, x00, x01);
            PG8_WAIT_K(); PG8_WAIT_L(0); PG8_BAR; PG8_MMA(1, 0, At, B0); if constexpr (!HALFN) PG8_MMA(1, 1, At, B1); PG8_BAR; PG8_SCHED;
        }
        if constexpr (Epi::NVM > 0) { static_assert(!GATHER, "pre-staging uses the static row offsets"); PG8_STAGE2(PG8_SA(1, 1), nA + kstep, va1[0], va1[1]); }
        if constexpr (ALIGN_EPI) { if (wr == 0) PG8_BAR; }
        { const int l_e = mk_lane(), fr_e = l_e & 15, fq_e = l_e >> 4;
          Unit ue = cur; asm volatile("" : "+s"(ue.pm), "+s"(ue.pn), "+s"(ue.e), "+s"(ue.lt), "+s"(ue.cnt));
          if constexpr (Epi::HAS_PRE) ue.lt = ui & 1;
          E(acc, ue, wr, wc, fr_e, fq_e); }
        PG8_VMFLUSH(Epi::NVM > 0 ? Epi::NVM : 0);
        if (!has_next) break;
#pragma unroll
        for (int a = 0; a < 2; ++a)
#pragma unroll
            for (int b = 0; b < 2; ++b)
#pragma unroll
                for (int m = 0; m < 4; ++m)
#pragma unroll
                    for (int n = 0; n < 2; ++n) acc[a][b][m][n] = (f32x4){0.f, 0.f, 0.f, 0.f};
        cur = nxt; cA = nA; cB = nB; ++ui;
        if constexpr (GATHER) { const u32x4 nv = *(const PG8_LAS u32x4*)(lds + NA_LDS_OFF + (wid * 64 + mk_lane()) * 16); va0[0] = nv[0]; va0[1] = nv[1]; va1[0] = nv[2]; va1[1] = nv[3]; }
        if constexpr (ALIGN_EPI) { if (wr == 1) PG8_BAR; }
    }
    PG8_WAIT_V(0);
    if constexpr (!ALIGN_EPI) { if (wr == 0) PG8_BAR; }
    PG8_BAR;
#undef PG8_SA
#undef PG8_SB
#undef PG8_STAGE2
#undef PG8_LDA
#undef PG8_LDB
#undef PG8_MMA
#undef PG8_LD8
#undef PG8_WAIT_V
#undef PG8_WAIT_L
#undef PG8_WAIT_K
#undef PG8_STAGE_B1
#undef PG8_VMFLUSH
#undef PG8_WAIT_VX
#undef PG8_BAR
#undef PG8_SCHED
}
}
#include <hip/hip_bf16.h>
#include <cmath>
namespace attn_body {
using bf16=__hip_bfloat16;
using bf16x8=__attribute__((ext_vector_type(8)))short;
using s16x4=__attribute__((ext_vector_type(4)))short;
using f32x16=__attribute__((ext_vector_type(16)))float;
using u32x4=__attribute__((ext_vector_type(4)))unsigned;
constexpr int BATCH=16,NHEAD=8,SEQ=4096,D=64,DM=3072,DMK=64;
constexpr int NW=8,QBLK=32,QB=QBLK*NW,KVBLK=64,NQB=SEQ/QB;
constexpr int ATTN_PITCH=DM, ATTN_UNIT_ROWS=QB;
__device__ __forceinline__ int crow(int r,int hi){return (r&3)+8*(r>>2)+4*hi;}
#define SBAR() __builtin_amdgcn_sched_barrier(0)
__device__ __forceinline__ void cmask(f32x16&p0,f32x16&p1,int jb,int qrel,int hi){
  const float NEG=-INFINITY; int kb=64*jb+4*hi;
  #pragma unroll
  for(int r=0;r<16;++r){int kv=kb+(r&3)+8*(r>>2); if(kv>qrel)p0[r]=NEG; if(kv+32>qrel)p1[r]=NEG;}
}

constexpr int NSLOT=3, SLOTB=8192;
constexpr int LDS_K=0, LDS_V=NSLOT*SLOTB, LDS_WS=2*NSLOT*SLOTB, LDS_OST=LDS_WS+NW*64*4, LDS_BT=LDS_OST+NW*4096, LDS_PT=LDS_BT+SEQ*4, LDS_BYTES=LDS_PT+BATCH*(SEQ/QB)*NHEAD*4;
constexpr float C2=0.125f*1.4426950408889634f;
__device__ __forceinline__ void glds16(const void*gsrc,unsigned lds_dst){unsigned keep;
  asm volatile("s_mov_b32 %0, m0\n\ts_mov_b32 m0, %2\n\ts_nop 0\n\tglobal_load_lds_dwordx4 %1, off\n\ts_mov_b32 m0, %0":"=&s"(keep):"v"(gsrc),"s"(lds_dst):"memory");}
__device__ __forceinline__ float max3f(float a,float b,float c){float r;asm("v_max3_f32 %0, %1, %2, %3":"=v"(r):"v"(a),"v"(b),"v"(c));return r;}
__device__ __forceinline__ float max2f(float a,float b){float r;asm("v_max_f32_e32 %0, %1, %2":"=v"(r):"v"(a),"v"(b));return r;}
__device__ __forceinline__ float fadd_s(float a,float b){float r;asm("v_add_f32_e32 %0, %1, %2":"=v"(r):"v"(a),"v"(b));return r;}
__device__ __forceinline__ float fsub_s(float a,float b){float r;asm("v_sub_f32_e32 %0, %1, %2":"=v"(r):"v"(a),"v"(b));return r;}
typedef float f32x2_t __attribute__((ext_vector_type(2))); typedef __bf16 bf16x2_t __attribute__((ext_vector_type(2)));
__device__ __forceinline__ unsigned cvtpk_s(float lo,float hi){f32x2_t v={lo,hi};bf16x2_t b=__builtin_convertvector(v,bf16x2_t);return __builtin_bit_cast(unsigned,b);}
#define WAIT_BAR(N) asm volatile("s_waitcnt vmcnt(" #N ") lgkmcnt(0)\n\ts_barrier":::"memory")

__device__ __forceinline__ void qkt(f32x16&p0,f32x16&p1,const char*Kslot,const bf16x8*qr,int r32,int hi){
  const char*kb=Kslot+hi*1024+r32*16;
  #pragma unroll
  for(int d0=0;d0<4;++d0){
    const bf16x8 b0=*reinterpret_cast<const bf16x8*>(kb+d0*2048);
    const bf16x8 b1=*reinterpret_cast<const bf16x8*>(kb+d0*2048+512);
    p0=__builtin_amdgcn_mfma_f32_32x32x16_bf16(b0,qr[d0],p0,0,0,0);p1=__builtin_amdgcn_mfma_f32_32x32x16_bf16(b1,qr[d0],p1,0,0,0);}
}
typedef __attribute__((address_space(3))) const char* lds_cptr;
typedef short v4i16_t __attribute__((ext_vector_type(4)));
__device__ __forceinline__ void kload8(bf16x8*kf,lds_cptr kp){
  kf[0]=*(const __attribute__((address_space(3))) bf16x8*)(kp);      kf[1]=*(const __attribute__((address_space(3))) bf16x8*)(kp+512);
  kf[2]=*(const __attribute__((address_space(3))) bf16x8*)(kp+2048); kf[3]=*(const __attribute__((address_space(3))) bf16x8*)(kp+2560);
  kf[4]=*(const __attribute__((address_space(3))) bf16x8*)(kp+4096); kf[5]=*(const __attribute__((address_space(3))) bf16x8*)(kp+4608);
  kf[6]=*(const __attribute__((address_space(3))) bf16x8*)(kp+6144); kf[7]=*(const __attribute__((address_space(3))) bf16x8*)(kp+6656);
}
__device__ __forceinline__ void kload2(bf16x8*kf,lds_cptr kp,int j){ kf[2*j]=*(const __attribute__((address_space(3))) bf16x8*)(kp+j*2048); kf[2*j+1]=*(const __attribute__((address_space(3))) bf16x8*)(kp+j*2048+512); }
__device__ __forceinline__ s16x4 vtr(lds_cptr p){ return __builtin_bit_cast(s16x4,__builtin_amdgcn_ds_read_tr16_b64_v4i16((__attribute__((address_space(3))) v4i16_t*)p)); }
__device__ __forceinline__ float rowmax(const f32x16&p0,const f32x16&p1){
  float a=max3f(p0[0],p0[1],p1[0]),b=max3f(p0[2],p0[3],p1[1]);a=max3f(a,p1[2],p1[3]);
  #pragma unroll
  for(int r=4;r<16;r+=4){a=max3f(a,p0[r],p0[r+1]);b=max3f(b,p0[r+2],p0[r+3]);a=max3f(a,p1[r],p1[r+1]);b=max3f(b,p1[r+2],p1[r+3]);}
  const float m=max2f(a,b);
  auto rr=__builtin_amdgcn_permlane32_swap(__float_as_uint(m),__float_as_uint(m),false,false);
  return max2f(__uint_as_float(rr[0]),__uint_as_float(rr[1]));
}
__device__ __forceinline__ void pv(f32x16*o,int vb,bf16x8 pa0,bf16x8 pa1,bf16x8 pa2,bf16x8 pa3){
  #pragma unroll
  for(int d0=0;d0<2;++d0){s16x4 lo[4],hi[4];
    #pragma unroll
    for(int ks=0;ks<4;++ks){
      asm volatile("ds_read_b64_tr_b16 %0,%1 offset:%c2":"=&v"(lo[ks]):"v"(vb),"i"(d0*4096+ks*1024):"memory");
      asm volatile("ds_read_b64_tr_b16 %0,%1 offset:%c2":"=&v"(hi[ks]):"v"(vb),"i"(d0*4096+ks*1024+512):"memory");}
    asm volatile("s_waitcnt lgkmcnt(0)":::"memory");SBAR();
    #define PK(k) (bf16x8){lo[k][0],lo[k][1],lo[k][2],lo[k][3],hi[k][0],hi[k][1],hi[k][2],hi[k][3]}
    o[d0]=__builtin_amdgcn_mfma_f32_32x32x16_bf16(pa0,PK(0),o[d0],0,0,0);
    o[d0]=__builtin_amdgcn_mfma_f32_32x32x16_bf16(pa1,PK(1),o[d0],0,0,0);
    o[d0]=__builtin_amdgcn_mfma_f32_32x32x16_bf16(pa2,PK(2),o[d0],0,0,0);
    o[d0]=__builtin_amdgcn_mfma_f32_32x32x16_bf16(pa3,PK(3),o[d0],0,0,0);
    #undef PK
  }
}

#ifndef ATTN_STORE16
#define ATTN_STORE16(p,v) (*(u32x4*)(p)=(v))
#endif
template<int THRL,bool NOMAX> __device__ __forceinline__ void attn_unit(int b,int h,int qb,const bf16*Q,const bf16*__restrict__ K,const bf16*__restrict__ V,bf16*O,const float*__restrict__ FL,const float*__restrict__ PT,const float prune,const float zref,char*shm,const int wave){
  const int lane=mk_lane(),r32=lane&31,hi=lane>>5; const int wid=wave; const int tid=wid*64+lane;
  const long rowbase=(long)b*SEQ; const int q0=qb*QB;
  const bf16*Qw=Q+(rowbase+q0+wid*QBLK)*DM+h*D;
  int skip=0; float dq=0.f; { const __attribute__((address_space(3))) float*ptb=(const __attribute__((address_space(3))) float*)((__attribute__((address_space(3))) char*)shm+LDS_PT)+(b*(SEQ/QB))*NHEAD+h; float ptv[SEQ/QB];
    #pragma unroll
    for(int p=0;p<SEQ/QB;++p)ptv[p]=ptb[p*NHEAD];
    float accb=0.f;
    #pragma unroll
    for(int p=SEQ/QB-2;p>=0;--p){ if(p<=qb-2){ accb+=ptv[p+1]; if(accb<prune&&skip==0)skip=p+1; } }
    #pragma unroll
    for(int p=0;p<SEQ/QB;++p) if(p==qb) dq=ptv[p]; }
  const bool aug=!NOMAX||(__builtin_amdgcn_readfirstlane(dq>zref?1:0)==0);
  skip=__builtin_amdgcn_readfirstlane(skip); const int j0=4*skip;
  const long kvbase=((long)(b*NHEAD+h))*SEQ; const bf16*Kh=K+(kvbase+(long)j0*KVBLK)*DMK,*Vh=V+(kvbase+(long)j0*KVBLK)*DMK;
  const unsigned lds0=(unsigned)(uintptr_t)shm;
  float*wsf=(float*)(shm+LDS_WS)+wid*64;
  const bf16*ksrc=Kh+(long)lane*DMK+wid*8;
  const bf16*vsrc=Vh+(long)(16*(wid&3)+(lane>>2))*DMK+(wid>>2)*32+(lane&3)*8;
  const unsigned kdst=lds0+LDS_K+wid*1024, vdst=lds0+LDS_V+wid*1024;
  #define DMA_K(t,slot) glds16(ksrc+(long)(t)*KVBLK*DMK,(unsigned)__builtin_amdgcn_readfirstlane(kdst+(slot)))
  #define DMA_V(t,slot) glds16(vsrc+(long)(t)*KVBLK*DMK,(unsigned)__builtin_amdgcn_readfirstlane(vdst+(slot)))
  const int vb0=(int)(lds0+LDS_V)+((lane>>4)&1)*32+(lane&3)*8+(4*hi+((lane&15)>>2))*64;
  const char*Kbase=shm+LDS_K; bf16x8 kf[8];
  const lds_cptr shm3=(lds_cptr)shm; const lds_cptr kp0=shm3+LDS_K+hi*1024+r32*16; const lds_cptr vp0=shm3+LDS_V+((lane>>4)&1)*32+(lane&3)*8+(4*hi+((lane&15)>>2))*64;
  const int NT=(q0+QB)/KVBLK-j0;
  DMA_K(0,0);DMA_V(0,0);DMA_K(1,SLOTB);
  bf16x8 qr[4];
  #pragma unroll
  for(int d0=0;d0<4;++d0)qr[d0]=*reinterpret_cast<const bf16x8*>(&Qw[(long)r32*DM+d0*16+hi*8]);
  { typedef float f32x4b __attribute__((ext_vector_type(4)));
    const int nk4=(q0+QB)>>2; const float*flb=FL+((long)(b*NHEAD+h))*SEQ; const __attribute__((address_space(3))) float*ptb=(const __attribute__((address_space(3))) float*)((__attribute__((address_space(3))) char*)shm+LDS_PT)+(b*(SEQ/QB))*NHEAD+h;
    const int g0=tid,g1=tid+512; const int kp0=g0>>6,kp1=g1>>6; float ref=0.f,c0=0.f,c1=0.f;
    #pragma unroll
    for(int p=0;p<SEQ/QB;++p){const float v=ptb[p*NHEAD]; if(p<=qb)ref+=v; if(p<kp0)c0+=v; if(p<kp1)c1+=v;}
    __attribute__((address_space(3))) float*btw=(__attribute__((address_space(3))) float*)((__attribute__((address_space(3))) char*)shm+LDS_BT);
    if(g0<nk4){const f32x4b f=*(const f32x4b*)(flb+4*g0); f32x4b w; w[0]=(ref-c0)-f[0];w[1]=(ref-c0)-f[1];w[2]=(ref-c0)-f[2];w[3]=(ref-c0)-f[3]; *(__attribute__((address_space(3))) f32x4b*)(btw+4*g0)=w;}
    if(g1<nk4){const f32x4b f=*(const f32x4b*)(flb+4*g1); f32x4b w; w[0]=(ref-c1)-f[0];w[1]=(ref-c1)-f[1];w[2]=(ref-c1)-f[2];w[3]=(ref-c1)-f[3]; *(__attribute__((address_space(3))) f32x4b*)(btw+4*g1)=w;}
  }
  const __attribute__((address_space(3))) float*btp=(const __attribute__((address_space(3))) float*)((__attribute__((address_space(3))) const char*)shm+LDS_BT)+4*hi+64*j0;
  typedef float f32x4b __attribute__((ext_vector_type(4)));
  #define LAS4 __attribute__((address_space(3)))
  #define BIASINIT(P0,P1,t) do{ const LAS4 float*bp_=btp+64*(t); \
    _Pragma("unroll") for(int g_=0;g_<4;++g_){ const f32x4b v_=*(const LAS4 f32x4b*)(bp_+8*g_); const f32x4b w_=*(const LAS4 f32x4b*)(bp_+32+8*g_); \
      P0[4*g_]=v_[0];P0[4*g_+1]=v_[1];P0[4*g_+2]=v_[2];P0[4*g_+3]=v_[3]; P1[4*g_]=w_[0];P1[4*g_+1]=w_[1];P1[4*g_+2]=w_[2];P1[4*g_+3]=w_[3]; } }while(0)
  bf16x8 mfr=__builtin_bit_cast(bf16x8,(u32x4){0u,0u,0u,0u});
  const bf16x8 knegf=__builtin_bit_cast(bf16x8,(u32x4){hi==0?0xBF80BF80u:0u,hi==0?0x0000BF80u:0u,0u,0u});
  #define MFRAG() do{ const unsigned hb_=__float_as_uint(mhat)&0xffff0000u; const float r1_=mhat-__uint_as_float(hb_); const unsigned mb_=__float_as_uint(r1_)&0xffff0000u; const float r2_=r1_-__uint_as_float(mb_); \
      const unsigned lb_=cvtpk_s(r2_,0.f)&0xffffu; mfr=__builtin_bit_cast(bf16x8,(u32x4){hi==0?((hb_>>16)|mb_):0u,hi==0?lb_:0u,0u,0u}); }while(0)
  float mhat=0.f,l_reg=0.f;f32x16 o[2];o[0]=f32x16{};o[1]=f32x16{};
  const int qrel=wid*QBLK+r32;
  #define CMASK(P0,P1,t) do{int jb_=(t)-(NT-4); if(jb_>=0)cmask(P0,P1,jb_,qrel,hi);}while(0)
  bool resc=false;
  #define START(P0,P1) do{ resc=false; \
    if constexpr(NOMAX){ if(aug){ mhat=((const LAS4 float*)((const LAS4 char*)shm+LDS_BT))[q0+qrel]; MFRAG(); \
      _Pragma("unroll") for(int r=0;r<16;++r){P0[r]=fsub_s(P0[r],mhat);P1[r]=fsub_s(P1[r],mhat);} } } \
    else { const float rm=rowmax(P0,P1); const float dl=rm; mhat=fadd_s(mhat,dl); MFRAG(); \
      _Pragma("unroll") for(int r=0;r<16;++r){P0[r]=fsub_s(P0[r],dl);P1[r]=fsub_s(P1[r],dl);} \
    } \
    _Pragma("unroll") for(int r=0;r<16;++r)P0[r]=__builtin_amdgcn_exp2f(P0[r]); }while(0)
  #define RESC() do{ if(resc){ asm volatile("s_waitcnt lgkmcnt(0)":::"memory"); \
      _Pragma("unroll") for(int d_=0;d_<2;++d_) _Pragma("unroll") for(int r=0;r<16;++r)o[d_][r]*=wsf[crow(r,hi)]; } }while(0)
  f32x16 pA0,pA1,pB0,pB1;
  int sl_prev=0,sl_cur=0,sl_next=SLOTB;
  #define ROT() do{sl_prev=sl_cur;sl_cur=sl_next;sl_next=(sl_next==(NSLOT-1)*SLOTB)?0:sl_next+SLOTB;}while(0)
  DMA_K(2,2*SLOTB);
  WAIT_BAR(3);
  BIASINIT(pA0,pA1,0);qkt(pA0,pA1,Kbase,qr,r32,hi);asm volatile("s_nop 15\n\ts_nop 7":"+v"(pA0),"+v"(pA1));CMASK(pA0,pA1,0);
  START(pA0,pA1);
  _Pragma("unroll") for(int r=0;r<16;++r)pA1[r]=__builtin_amdgcn_exp2f(pA1[r]);
  BIASINIT(pB0,pB1,1);
  WAIT_BAR(0);
  DMA_K(3,0);DMA_V(1,SLOTB);
  ROT();
  kload8(kf,kp0+sl_cur);
  WAIT_BAR(2);
  s16x4 vlo[8],vhi[8]; u32x4 pw0,pw1,pw2,pw3;
  #define PKW(P,B) cvtpk_s(P[B],P[B+1])
  #define PAF(k) __builtin_bit_cast(bf16x8,pw##k)
  #define VFR(i) (bf16x8){vlo[i][0],vlo[i][1],vlo[i][2],vlo[i][3],vhi[i][0],vhi[i][1],vhi[i][2],vhi[i][3]}
  #define PIN(x) asm volatile("":"+v"(x))
  #define MX3(a,b,c) __builtin_fmaxf(__builtin_fmaxf((a),(b)),(c))
  #define GAPA(MF,A0,A1,A2,A3,W0,W1,PW) do{ MF; sacc+=A0; sacc+=A1; sacc+=A2; sacc+=A3; PIN(sacc); W0; W1; PIN(PW); SBAR(); }while(0)
  #define EX(v) __builtin_amdgcn_exp2f(v)
  #define GAPB(MF,X,B) do{ MF; X[B]=EX(X[B]); X[B+1]=EX(X[B+1]); X[B+2]=EX(X[B+2]); X[B+3]=EX(X[B+3]); PIN(X); SBAR(); }while(0)
  #define BLDP(k,PX) do{ const f32x4b t_=*(const LAS4 f32x4b*)(bq_+((k)&1)*32+8*((k)>>1)); PX[4*((k)>>1)]=t_[0]; PX[4*((k)>>1)+1]=t_[1]; PX[4*((k)>>1)+2]=t_[2]; PX[4*((k)>>1)+3]=t_[3]; }while(0)
  #define BSUBK(k,PX) do{ PX[4*((k)>>1)]=fsub_s(tb##k[0],mhat); PX[4*((k)>>1)+1]=fsub_s(tb##k[1],mhat); PX[4*((k)>>1)+2]=fsub_s(tb##k[2],mhat); PX[4*((k)>>1)+3]=fsub_s(tb##k[3],mhat); PIN(PX); }while(0)
  #define GAPBX(MF,X,B,LD,SB) do{ MF; X[B]=EX(X[B]); X[B+1]=EX(X[B+1]); X[B+2]=EX(X[B+2]); X[B+3]=EX(X[B+3]); PIN(X); LD; SB; SBAR(); }while(0)
  #define VRD(i) do{ vlo[i]=vtr(vp_+(((i)>>2)*4096+((i)&3)*1024)); vhi[i]=vtr(vp_+(((i)>>2)*4096+((i)&3)*1024+512)); }while(0)
  #define KRD(G,j) do{ if(G){ kload2(kf,kp0+sl_next,j); SBAR(); } }while(0)
  #define STEP(C0,C1,P0,P1,t,GK,GV,GL) do{ SBAR(); \
    const lds_cptr vp_=vp0+sl_prev; \
    VRD(0); SBAR(); float sacc=(P0[0]+P0[1]); \
    GAPA(C0=__builtin_amdgcn_mfma_f32_32x32x16_bf16(kf[0],qr[0],C0,0,0,0), P0[2],P0[3],P0[4],P0[5],     pw0[0]=PKW(P0,0), pw0[1]=PKW(P0,2), pw0); \
    VRD(4); SBAR(); GAPA(C1=__builtin_amdgcn_mfma_f32_32x32x16_bf16(kf[1],qr[0],C1,0,0,0), P0[6],P0[7],P0[8],P0[9],     pw0[2]=PKW(P0,4), pw0[3]=PKW(P0,6), pw0); \
    VRD(1); SBAR(); GAPA(C0=__builtin_amdgcn_mfma_f32_32x32x16_bf16(kf[2],qr[1],C0,0,0,0),   P0[10],P0[11],P0[12],P0[13], pw1[0]=PKW(P0,8), pw1[1]=PKW(P0,10), pw1); \
    VRD(5); SBAR(); GAPA(C1=__builtin_amdgcn_mfma_f32_32x32x16_bf16(kf[3],qr[1],C1,0,0,0),   P0[14],P0[15],P1[0],P1[1],   pw1[2]=PKW(P0,12),pw1[3]=PKW(P0,14), pw1); \
    VRD(2); SBAR(); GAPA(C0=__builtin_amdgcn_mfma_f32_32x32x16_bf16(kf[4],qr[2],C0,0,0,0),   P1[2],P1[3],P1[4],P1[5],     pw2[0]=PKW(P1,0), pw2[1]=PKW(P1,2), pw2); \
    VRD(6); SBAR(); GAPA(C1=__builtin_amdgcn_mfma_f32_32x32x16_bf16(kf[5],qr[2],C1,0,0,0),   P1[6],P1[7],P1[8],P1[9],     pw2[2]=PKW(P1,4), pw2[3]=PKW(P1,6), pw2); \
    VRD(3); SBAR(); GAPA(C0=__builtin_amdgcn_mfma_f32_32x32x16_bf16(kf[6],qr[3],C0,0,0,0),   P1[10],P1[11],P1[12],P1[13], pw3[0]=PKW(P1,8), pw3[1]=PKW(P1,10), pw3); \
    VRD(7); SBAR(); GAPA(C1=__builtin_amdgcn_mfma_f32_32x32x16_bf16(kf[7],qr[3],C1,0,0,0),   P1[14],P1[15],0.f,0.f,       pw3[2]=PKW(P1,12),pw3[3]=PKW(P1,14), pw3); \
    l_reg+=sacc; \
    if(aug){ C0=__builtin_amdgcn_mfma_f32_32x32x16_bf16(knegf,mfr,C0,0,0,0); C1=__builtin_amdgcn_mfma_f32_32x32x16_bf16(knegf,mfr,C1,0,0,0); } \
    if(GK){DMA_K((t)+3,sl_cur);} if(GV){DMA_V((t)+1,sl_next);} \
    CMASK(C0,C1,t); \
    if constexpr(!NOMAX){ float a=MX3(C0[0],C0[1],C1[0]),b=MX3(C0[2],C0[3],C1[1]); a=MX3(a,C1[2],C1[3]); \
      _Pragma("unroll") for(int r=4;r<16;r+=4){a=MX3(a,C0[r],C0[r+1]);b=MX3(b,C0[r+2],C0[r+3]);a=MX3(a,C1[r],C1[r+1]);b=MX3(b,C1[r+2],C1[r+3]);} \
      float rm=__builtin_fmaxf(a,b); { auto rr=__builtin_amdgcn_permlane32_swap(__float_as_uint(rm),__float_as_uint(rm),false,false); rm=__builtin_fmaxf(__uint_as_float(rr[0]),__uint_as_float(rr[1])); } \
      resc=false; \
      if(__builtin_expect(__any(rm>(float)THRL),0)){ const float dl=__builtin_fmaxf(rm,0.f); mhat+=dl; \
        _Pragma("unroll") for(int r=0;r<16;++r){C0[r]-=dl;C1[r]-=dl;} \
        const float f=__builtin_amdgcn_exp2f(-dl); l_reg*=f; if(hi==0)wsf[r32]=f; resc=true; MFRAG(); } } \
    SBAR(); \
    const LAS4 float*bq_=btp+64*((t)+1); \
    GAPBX(o[0]=__builtin_amdgcn_mfma_f32_32x32x16_bf16(PAF(0),VFR(0),o[0],0,0,0), C0,0,  BLDP(0,P0), (void)0); \
    GAPBX(o[1]=__builtin_amdgcn_mfma_f32_32x32x16_bf16(PAF(0),VFR(4),o[1],0,0,0), C0,4,  BLDP(1,P1), (void)0); \
    KRD(GL,0); GAPBX(o[0]=__builtin_amdgcn_mfma_f32_32x32x16_bf16(PAF(1),VFR(1),o[0],0,0,0), C0,8,  BLDP(2,P0), (void)0); \
    KRD(GL,1); GAPBX(o[1]=__builtin_amdgcn_mfma_f32_32x32x16_bf16(PAF(1),VFR(5),o[1],0,0,0), C0,12, BLDP(3,P1), (void)0); \
    KRD(GL,2); GAPBX(o[0]=__builtin_amdgcn_mfma_f32_32x32x16_bf16(PAF(2),VFR(2),o[0],0,0,0), C1,0,  BLDP(4,P0), (void)0); \
    KRD(GL,3); GAPBX(o[1]=__builtin_amdgcn_mfma_f32_32x32x16_bf16(PAF(2),VFR(6),o[1],0,0,0), C1,4,  BLDP(5,P1), (void)0); \
    GAPBX(o[0]=__builtin_amdgcn_mfma_f32_32x32x16_bf16(PAF(3),VFR(3),o[0],0,0,0), C1,8,  BLDP(6,P0), (void)0); \
    GAPBX(o[1]=__builtin_amdgcn_mfma_f32_32x32x16_bf16(PAF(3),VFR(7),o[1],0,0,0), C1,12, BLDP(7,P1), (void)0); \
    PIN(P0); PIN(P1); SBAR(); \
    }while(0)
  int t=1;
  #undef CMASK
  #define CMASK(P0,P1,t) do{}while(0)
  for(;t+5<NT;t+=2){
    STEP(pB0,pB1,pA0,pA1,t,true,true,true);     WAIT_BAR(2); RESC(); ROT();
    STEP(pA0,pA1,pB0,pB1,t+1,true,true,true);   WAIT_BAR(2); RESC(); ROT();
  }
  #undef CMASK
  #define CMASK(P0,P1,t) do{int jb_=(t)-(NT-4); if(jb_>=0)cmask(P0,P1,jb_,qrel,hi);}while(0)
  #define ENDW(tt) do{ if((tt)+3<NT){WAIT_BAR(2);} else if((tt)+2<NT){WAIT_BAR(1);} else {WAIT_BAR(0);} }while(0)
  for(;t+1<NT;t+=2){
    STEP(pB0,pB1,pA0,pA1,t,(t+3<NT),(t+1<NT),(t+1<NT));       ENDW(t);   RESC(); ROT();
    STEP(pA0,pA1,pB0,pB1,t+1,(t+4<NT),(t+2<NT),(t+2<NT));     ENDW(t+1); RESC(); ROT();
  }
  STEP(pB0,pB1,pA0,pA1,NT-1,false,false,false); RESC();
  { float sacc=pB0[0]+pB0[1]; _Pragma("unroll") for(int r=2;r<16;++r)sacc+=pB0[r]; _Pragma("unroll") for(int r=0;r<16;++r)sacc+=pB1[r]; l_reg+=sacc;
    pw0=(u32x4){PKW(pB0,0),PKW(pB0,2),PKW(pB0,4),PKW(pB0,6)};pw1=(u32x4){PKW(pB0,8),PKW(pB0,10),PKW(pB0,12),PKW(pB0,14)};pw2=(u32x4){PKW(pB1,0),PKW(pB1,2),PKW(pB1,4),PKW(pB1,6)};pw3=(u32x4){PKW(pB1,8),PKW(pB1,10),PKW(pB1,12),PKW(pB1,14)};
    SBAR(); pv(o,vb0+sl_cur,PAF(0),PAF(1),PAF(2),PAF(3)); }
  #undef PKW
  #undef PAF
  #undef VFR
  #undef PIN
  #undef MX3
  #undef GAPA
  #undef GAPB
  #undef GAPBX
  #undef BLDK
  #undef BSUBK
  #undef EX
  #undef VRD
  #undef KRD
  #undef STEP
  #undef ENDW
  {auto rr=__builtin_amdgcn_permlane32_swap(__float_as_uint(l_reg),__float_as_uint(l_reg),false,false);l_reg=__uint_as_float(rr[0])+__uint_as_float(rr[1]);}
  if(hi==0)wsf[32+r32]=l_reg;asm volatile("s_waitcnt lgkmcnt(0)":::"memory");
  float rli[16];
  #pragma unroll
  for(int r=0;r<16;++r)rli[r]=__builtin_amdgcn_rcpf(wsf[32+crow(r,hi)]);
  bf16*Ow=O+(rowbase+q0+wid*QBLK)*DM+h*D;
  { bf16*stg=(bf16*)(shm+LDS_OST)+wid*2048;
    #pragma unroll
    for(int r=0;r<16;++r){const int orow=crow(r,hi);
      #pragma unroll
      for(int d0=0;d0<2;++d0)stg[orow*64+d0*32+r32]=__float2bfloat16(o[d0][r]*rli[r]);}
    asm volatile("s_waitcnt lgkmcnt(0)":::"memory");
    #pragma unroll
    for(int i=0;i<4;++i){const int row=i*8+(lane>>3),ch=lane&7; const u32x4 v=*(const u32x4*)(stg+row*64+ch*8); ATTN_STORE16(Ow+(long)row*DM+ch*8,v);} }
  asm volatile("s_waitcnt lgkmcnt(0)\n\ts_barrier":::"memory");
  #undef DMA_K
  #undef DMA_V
  #undef BIASINIT
  #undef LAS4
  #undef CMASK
  #undef START
  #undef RESC
  #undef ROT
}
constexpr int ATTN_LDS_BYTES=LDS_BYTES;
struct AttnTensors { const bf16* Q; const bf16* K; const bf16* V; bf16* O; const float* FL; const float* PT; float prune; int nomax; float zref; };
struct AttnUnit { int bh; int qb; };
struct DynOrder {
  unsigned* ctr; volatile __attribute__((address_space(3))) unsigned* word; int wave;
  __device__ __forceinline__ void prime(unsigned&pre)const{ pre=0u; if(wave==0&&mk_lane()==0) pre=__hip_atomic_fetch_add(ctr,1u,__ATOMIC_RELAXED,__HIP_MEMORY_SCOPE_AGENT); }
  __device__ __forceinline__ bool next(int,AttnUnit&u,unsigned&pre)const{
    if(wave==0&&mk_lane()==0){ *word=pre; pre=__hip_atomic_fetch_add(ctr,1u,__ATOMIC_RELAXED,__HIP_MEMORY_SCOPE_AGENT); }
    asm volatile("s_waitcnt lgkmcnt(0)\n\ts_barrier":::"memory");
    const unsigned L=__builtin_amdgcn_readfirstlane(*word);
    asm volatile("s_waitcnt lgkmcnt(0)\n\ts_barrier":::"memory");
    if(L>=(unsigned)(BATCH*NHEAD*NQB))return false;
    u.qb=NQB-1-(int)(L/(BATCH*NHEAD)); u.bh=(int)(L%(BATCH*NHEAD)); return true; }
  __device__ __forceinline__ void a_ready(const AttnUnit&)const{}
  __device__ __forceinline__ void done(const AttnUnit&)const{}
};
template<class Sched,int THRL=8> __device__ __forceinline__ void attn_phase(char*lds,const AttnTensors&T,const Sched&S,const int wave){
  AttnUnit u; unsigned pre; S.prime(pre);
  { const int tid_=wave*64+mk_lane(); typedef float f4_ __attribute__((ext_vector_type(4)));
    static_assert(BATCH*(SEQ/QB)*NHEAD==NW*64*4,"one 16-byte piece per thread");
    *(__attribute__((address_space(3))) f4_*)((__attribute__((address_space(3))) char*)lds+LDS_PT+16*tid_)=*(const f4_*)(T.PT+4*tid_);
    asm volatile("s_waitcnt vmcnt(0) lgkmcnt(0)\n\ts_barrier":::"memory"); }
  if(T.nomax){ for(int i=0;S.next(i,u,pre);++i){ S.a_ready(u); attn_unit<THRL,true>(u.bh/NHEAD,u.bh%NHEAD,u.qb,T.Q,T.K,T.V,T.O,T.FL,T.PT,T.prune,T.zref,lds,wave); S.done(u); } }
  else { for(int i=0;S.next(i,u,pre);++i){ S.a_ready(u); attn_unit<THRL,false>(u.bh/NHEAD,u.bh%NHEAD,u.qb,T.Q,T.K,T.V,T.O,T.FL,T.PT,T.prune,T.zref,lds,wave); S.done(u); } }
}
#undef SBAR
#undef WAIT_BAR
}
constexpr int NWAVES = 8;
#ifndef MK_N_LAUNCHES
#define MK_N_LAUNCHES 1
#endif
constexpr int N_PHASES = 10;
constexpr int N_LAUNCHES = MK_N_LAUNCHES;

constexpr int BATCH = 16, SEQ = 4096, D = 1024, M = BATCH * SEQ, NPANEL = M / 256, PPS = SEQ / 256;
constexpr int NH = 8, HD = 64, CW = 512;
constexpr int PP5 = 5120;
constexpr int INC = 5128, PP = 3072;
constexpr int NE = 32, NG = 4, EPG = 8, DE = 256;
constexpr int MODC = 6 * D;
constexpr float EPS = 1e-6f;
constexpr float LOG2E = 1.4426950408889634f;
constexpr int PC_U = 0, PC_B = 512, PC_C = 1024, PC_Q = 1536, PC_GC = 2048, PC_GA = 2560;
constexpr int LISTCAP = 65536;
constexpr int AROWS = 2 * M + NE * 256;
constexpr int NLOG = 80;

constexpr size_t MiB = 1u << 20;
constexpr size_t WS_CTL = 0, CTL_ZERO_BYTES = 1 * MiB;
constexpr size_t WS_WIN = 1 * MiB;
constexpr size_t WS_WOC = 11 * MiB;
constexpr size_t WS_WOA = 12 * MiB;
constexpr size_t WS_WO = 13 * MiB;
constexpr size_t WS_WR = 15 * MiB;
constexpr size_t WS_WGU = 16 * MiB;
constexpr size_t WS_WD = 48 * MiB;
constexpr size_t WS_MODP = 64 * MiB;
constexpr size_t WS_MOD = 70 * MiB;
constexpr size_t WS_PT = WS_MOD + 512 * 1024;
constexpr size_t WS_FL = 71 * MiB;
constexpr size_t WS_WF = 73 * MiB;
constexpr size_t WS_POS = 74 * MiB;
constexpr size_t WS_LIST = 76 * MiB;
constexpr size_t WS_WLIST = 84 * MiB;
constexpr size_t WS_LOG = 92 * MiB;
constexpr size_t WS_H = 112 * MiB;
constexpr size_t WS_PROJ = 240 * MiB;
constexpr size_t WS_KB = 624 * MiB;
constexpr size_t WS_VB = 688 * MiB;
constexpr size_t WS_ACT = 240 * MiB;
constexpr size_t WS_Y = 308 * MiB;
constexpr size_t WS_DELTA = 752 * MiB;
constexpr size_t WS_H8 = 880 * MiB;
constexpr size_t WS_WIN8 = 944 * MiB;
constexpr size_t WS_RS = 73 * MiB + 256 * 1024;
constexpr size_t WS_CS = 73 * MiB + 640 * 1024;
constexpr size_t WS_CSO = WS_CS + 32 * 1024;
constexpr size_t WS_EX = WS_CS + 64 * 1024;
constexpr size_t WS_WRB = 950 * MiB;
constexpr size_t WS_BR = 958 * MiB;
constexpr size_t WS_END = 959 * MiB;
static_assert(WS_PROJ + (size_t)M * PP * 2 <= WS_KB && WS_Y + (size_t)AROWS * 1024 <= WS_KB && WS_DELTA + (size_t)M * 1024 * 2 <= 880 * MiB && WS_ACT + (size_t)AROWS * 256 * 2 <= WS_Y && WS_Y + (size_t)AROWS * 1024 * 2 <= WS_END && WS_PROJ + (size_t)M * PP * 2 <= WS_END, "d_ws map");
constexpr int CW_TMO = 0, CW_CODE = 1;
constexpr int CW_CNT = 1024;
constexpr int CW_ATTQ = 2048;
constexpr int CW_CMAX = 16384;
constexpr int CW_BAR = 4096;

constexpr int RING_OFF = 0, RING_BYTES = 131072;
constexpr int LDSCTL_OFF = RING_BYTES, MISC_OFF = LDSCTL_OFF + 320;
constexpr int TAB_OFF = LDSCTL_OFF + 1024;
constexpr int PTR_OFF = LDSCTL_OFF + 512;
constexpr int OST_OFF = 145408;
constexpr int LDS_BYTES = 163840;
static_assert(TAB_OFF + 1024 + 4096 <= pg8::NA_LDS_OFF && pg8::NA_LDS_OFF + 8192 <= OST_OFF && OST_OFF + 16384 == pg8::RAW_LDS_OFF && pg8::RAW_LDS_OFF + 1024 <= LDS_BYTES, "LDS map");

#define GAS __attribute__((address_space(1)))
#define LAS __attribute__((address_space(3)))
typedef unsigned short bf16;
typedef unsigned v4u __attribute__((ext_vector_type(4)));
typedef unsigned v2u __attribute__((ext_vector_type(2)));
typedef float f32x4 __attribute__((ext_vector_type(4)));
typedef GAS unsigned gu32;
#define RLX_AGENT __ATOMIC_RELAXED, __HIP_MEMORY_SCOPE_AGENT
#define LDS_WAIT() asm volatile("s_waitcnt lgkmcnt(0)" ::: "memory")
#define VM_WAIT() asm volatile("s_waitcnt vmcnt(0)" ::: "memory")
__device__ __forceinline__ unsigned f2bf(float f) { unsigned u = __builtin_bit_cast(unsigned, f); return (u + 0x7fffu + ((u >> 16) & 1u)) >> 16; }
__device__ __forceinline__ unsigned pk2(float lo, float hi) { return f2bf(lo) | (f2bf(hi) << 16); }
__device__ __forceinline__ float bflo(unsigned w) { return __uint_as_float(w << 16); }
__device__ __forceinline__ float bfhi(unsigned w) { return __uint_as_float(w & 0xffff0000u); }
__device__ __forceinline__ float clamp_fp8(float x) { return __builtin_amdgcn_fmed3f(x, -448.0f, 448.0f); }
__device__ __forceinline__ unsigned pk4_fp8(float a, float b, float c, float d) { int w = __builtin_amdgcn_cvt_pk_fp8_f32(clamp_fp8(a), clamp_fp8(b), 0, false); w = __builtin_amdgcn_cvt_pk_fp8_f32(clamp_fp8(c), clamp_fp8(d), w, true); return (unsigned)w; }
__device__ __forceinline__ unsigned pk4_i8(float a, float b, float c, float d) {
    const unsigned ua = __float_as_uint(a + 12582912.0f), ub = __float_as_uint(b + 12582912.0f), uc = __float_as_uint(c + 12582912.0f), ud = __float_as_uint(d + 12582912.0f);
    const unsigned lo = __builtin_amdgcn_perm(ub, ua, 0x0c0c0400u), hi = __builtin_amdgcn_perm(ud, uc, 0x04000c0cu);
    return lo | hi;
}
constexpr float Y8_SCALE = 16.0f;
constexpr float M8_SCALE = 8.0f;
constexpr float A8_SCALE = 64.0f;
constexpr float D8_SCALE = 16.0f;
constexpr float W8_SCALE = 32.0f;

#define XB_TMO      128
#define XB_XCNT(j)  (256  + 64 * (j))
#define XB_XSUB(j)  (1280 + 64 * (j))
#define XB_XGEN(j)  (2304 + 64 * (j))
#define XB_TOP      3328
#define XB_TOPGEN   3392
#define XCD_BAR_WORDS 3456
#define XB_SPIN_CAP (1u << 18)

__device__ __forceinline__ unsigned xb_ld(unsigned* p)              { return __hip_atomic_load(p, __ATOMIC_RELAXED, __HIP_MEMORY_SCOPE_AGENT); }
__device__ __forceinline__ unsigned xb_add(unsigned* p, unsigned v) { return __hip_atomic_fetch_add(p, v, __ATOMIC_RELAXED, __HIP_MEMORY_SCOPE_AGENT); }
__device__ __forceinline__ unsigned xb_xcc_id() { return (unsigned)__builtin_amdgcn_s_getreg((3 << 11) | 20) & 0xFu; }
#define XB_SPIN(cond, bar) do { unsigned _sp = 0; while (cond) { __builtin_amdgcn_s_sleep(1); \
    if ((++_sp & 255u) == 0u) { if (xb_ld(&(bar)[XB_TMO])) break; if (_sp > XB_SPIN_CAP) { atomicAdd(&(bar)[XB_TMO], 1u); break; } } } } while (0)

struct XcdBarrier {
    unsigned* bar; unsigned x;
    volatile LAS unsigned* st;
};
__device__ __forceinline__ XcdBarrier xcd_barrier_post(unsigned* bar, volatile LAS unsigned* st, const bool t0) {
    XcdBarrier b; b.bar = bar; b.x = xb_xcc_id(); b.st = st;
    if (t0) (void)xb_add(&bar[XB_XCNT(b.x)], 1u);
    return b;
}
__device__ __forceinline__ void xcd_barrier_complete(unsigned* bar, unsigned x, unsigned& nloc, unsigned& nx) {
    const unsigned G = gridDim.x * gridDim.y * gridDim.z;
    unsigned sum, cnt, mine, sp = 0u;
    for (;;) {
        sum = 0u; cnt = 0u; mine = 0u;
#pragma unroll
        for (unsigned j = 0; j < 16; ++j) { const unsigned c = xb_ld(&bar[XB_XCNT(j)]); sum += c; cnt += (c > 0u) ? 1u : 0u; mine = (j == x) ? c : mine; }
        if (sum == G) break;
        __builtin_amdgcn_s_sleep(1);
        if ((++sp & 255u) == 0u) { if (xb_ld(&bar[XB_TMO])) break; if (sp > XB_SPIN_CAP) { atomicAdd(&bar[XB_TMO], 1u); break; } }
    }
    nloc = mine > 0u ? mine : 1u; nx = cnt > 0u ? cnt : 1u;
}
__device__ __forceinline__ void xcd_barrier(const XcdBarrier& b, const bool t0) {
    asm volatile("s_waitcnt vmcnt(0)" ::: "memory");
    __syncthreads();
    if (t0) {
        unsigned* bar = b.bar;
        __builtin_amdgcn_s_waitcnt(0);
        unsigned nloc = b.st[0], nx = b.st[1];
        if (nloc == 0u) { xcd_barrier_complete(bar, b.x, nloc, nx); b.st[0] = nloc; b.st[1] = nx; }
        const unsigned old = xb_add(&bar[XB_XSUB(b.x)], 1u);
        const unsigned gen = old / nloc;
        if (old + 1u == (gen + 1u) * nloc) {
            __builtin_amdgcn_fence(__ATOMIC_RELEASE, "agent");
            asm volatile("s_waitcnt vmcnt(0)" ::: "memory");
            const unsigned og = xb_add(&bar[XB_TOP], 1u);
            const unsigned tg = og / nx;
            if (og + 1u == (tg + 1u) * nx) xb_add(&bar[XB_TOPGEN], 1u);
            else XB_SPIN(xb_ld(&bar[XB_TOPGEN]) == tg, bar);
            __builtin_amdgcn_fence(__ATOMIC_ACQUIRE, "agent");
            xb_add(&bar[XB_XGEN(b.x)], 1u);
            asm volatile("s_waitcnt vmcnt(0)" ::: "memory");
        } else {
            XB_SPIN(xb_ld(&bar[XB_XGEN(b.x)]) == gen, bar);
            __builtin_amdgcn_fence(__ATOMIC_ACQUIRE, "agent");
            asm volatile("s_waitcnt vmcnt(0)" ::: "memory");
        }
    }
    __syncthreads();
}

namespace pg8 {

__device__ __forceinline__ u32x4 dpp_ror8(u32x4 v) { u32x4 r; r.x = __builtin_amdgcn_update_dpp(0, (int)v.x, 0x128, 0xf, 0xf, false); r.y = __builtin_amdgcn_update_dpp(0, (int)v.y, 0x128, 0xf, 0xf, false);
    r.z = __builtin_amdgcn_update_dpp(0, (int)v.z, 0x128, 0xf, 0xf, false); r.w = __builtin_amdgcn_update_dpp(0, (int)v.w, 0x128, 0xf, 0xf, false); return r; }
__device__ __forceinline__ void store_rows64(bf16_t* base, size_t ld, int fr, int fq, u32x4 w0, u32x4 w1, PG8_LAS unsigned char* ost, int lane) {
    *(PG8_LAS u32x4*)(ost + fr * 128 + ((fq ^ (fr & 7)) << 4)) = w0; *(PG8_LAS u32x4*)(ost + fr * 128 + (((fq + 4) ^ (fr & 7)) << 4)) = w1;
    asm volatile("s_waitcnt lgkmcnt(0)" ::: "memory");
    const int r = lane >> 3, c = lane & 7;
    const u32x4 a = *(const PG8_LAS u32x4*)(ost + r * 128 + ((c ^ (r & 7)) << 4)), b = *(const PG8_LAS u32x4*)(ost + (r + 8) * 128 + ((c ^ (r & 7)) << 4));
    asm volatile("s_waitcnt lgkmcnt(0)" ::: "memory");
    *(u32x4*)(base + (size_t)((unsigned)r * (unsigned)ld + 8u * (unsigned)c)) = a; *(u32x4*)(base + (size_t)((unsigned)(r + 8) * (unsigned)ld + 8u * (unsigned)c)) = b;
}
__device__ __forceinline__ void store_rows32(unsigned char* base, size_t ldb, int fr, int fq, u32x4 w, PG8_LAS unsigned char* ost, int lane) {
    *(PG8_LAS u32x4*)(ost + fr * 64 + ((fq ^ ((fr >> 1) & 3)) << 4)) = w;
    asm volatile("s_waitcnt lgkmcnt(0)" ::: "memory");
    const int r = lane >> 2, c = lane & 3;
    const u32x4 a = *(const PG8_LAS u32x4*)(ost + r * 64 + ((c ^ ((r >> 1) & 3)) << 4));
    asm volatile("s_waitcnt lgkmcnt(0)" ::: "memory");
    *(u32x4*)(base + (size_t)((unsigned)r * (unsigned)ldb + 16u * (unsigned)c)) = a;
}
__device__ __forceinline__ void store_rows32_2x8(unsigned char* base, size_t ldb, int fr, int fq, v2u lo, v2u hi, PG8_LAS unsigned char* ost, int lane) {
    *(PG8_LAS v2u*)(ost + fr * 64 + ((((8 * fq) >> 4) ^ ((fr >> 1) & 3)) << 4) + ((8 * fq) & 15)) = lo;
    *(PG8_LAS v2u*)(ost + fr * 64 + ((((32 + 8 * fq) >> 4) ^ ((fr >> 1) & 3)) << 4) + ((8 * fq) & 15)) = hi;
    asm volatile("s_waitcnt lgkmcnt(0)" ::: "memory");
    const int r = lane >> 2, c = lane & 3;
    const u32x4 a = *(const PG8_LAS u32x4*)(ost + r * 64 + ((c ^ ((r >> 1) & 3)) << 4));
    asm volatile("s_waitcnt lgkmcnt(0)" ::: "memory");
    *(u32x4*)(base + (size_t)((unsigned)r * (unsigned)ldb + 16u * (unsigned)c)) = a;
}
struct EpiBf16Plain {
    static constexpr bool PERM = true, HAS_MID = false, HAS_SEG = false; static constexpr bool HAS_PRE = false; static constexpr int NVM = 0;
    bf16_t* O; int ldc;
    __device__ __forceinline__ void operator()(const f32x4 (&acc)[2][2][4][2], const Unit& u, int wr, int wc, int fr, int fq) const {
        const int row0 = u.pm * BM + wr * 64 + fr, col0 = u.pn * BM + wc * 32 + 8 * fq;
#pragma unroll
        for (int ai = 0; ai < 2; ++ai)
#pragma unroll
            for (int m = 0; m < 4; ++m) { bf16_t* rowp = O + (size_t)(row0 + ai * HALF + m * 16) * ldc + col0;
#pragma unroll
                for (int bj = 0; bj < 2; ++bj) { const f32x4 v0 = acc[ai][bj][m][0], v1 = acc[ai][bj][m][1];
                    u32x4 w; w.x = cvt_pk_bf16(v0[0], v0[1]); w.y = cvt_pk_bf16(v0[2], v0[3]); w.z = cvt_pk_bf16(v1[0], v1[1]); w.w = cvt_pk_bf16(v1[2], v1[3]);
                    *(u32x4*)(rowp + bj * HALF) = w; } }
    }
};

struct EpiFp8Plain {
    static constexpr bool PERM = true, HAS_MID = false, HAS_SEG = false; static constexpr bool HAS_PRE = false; static constexpr int NVM = 0;
    unsigned char* O; int ldc; float scale; PG8_LAS unsigned char* ost0;
    __device__ __forceinline__ void operator()(const f32x4 (&acc)[2][2][4][2], const Unit& u, int wr, int wc, int fr, int fq) const {
        const int rowt = u.pm * BM + wr * 64, colw = u.pn * BM + wc * 64; const int lane = fq * 16 + fr; PG8_LAS unsigned char* ost = ost0 + (wr * 4 + wc) * 2048;
#pragma unroll
        for (int ai = 0; ai < 2; ++ai)
#pragma unroll
            for (int m = 0; m < 4; ++m) { v2u w[2];
#pragma unroll
                for (int bj = 0; bj < 2; ++bj) { const f32x4 v0 = acc[ai][bj][m][0] * scale, v1 = acc[ai][bj][m][1] * scale; w[bj].x = pk4_fp8(v0[0], v0[1], v0[2], v0[3]); w[bj].y = pk4_fp8(v1[0], v1[1], v1[2], v1[3]); }
                store_rows32_2x8(O + (size_t)(rowt + ai * HALF + m * 16) * ldc + colw, (size_t)ldc, fr, fq, w[0], w[1], ost, lane); }
    }
};
template <int MODE> struct EpiGate {
    static constexpr bool PERM = true, HAS_MID = false, HAS_SEG = false; static constexpr bool HAS_PRE = false; static constexpr int NVM = 0;
    const bf16_t* G; int ldg, gcol; bf16_t* T; int ldt;
    __device__ __forceinline__ void operator()(const f32x4 (&acc)[2][2][4][2], const Unit& u, int wr, int wc, int fr, int fq) const {
        const int row0 = u.pm * BM + wr * 64 + fr, col0 = u.pn * BM + wc * 32 + 8 * fq;
#pragma unroll
        for (int ai = 0; ai < 2; ++ai)
#pragma unroll
            for (int m = 0; m < 4; ++m) { const size_t r = (size_t)(row0 + ai * HALF + m * 16);
#pragma unroll
                for (int bj = 0; bj < 2; ++bj) { const int c = col0 + bj * HALF;
                    const u32x4 g = *(const u32x4*)(G + r * ldg + gcol + c);
                    const f32x4 a0 = acc[ai][bj][m][0], a1 = acc[ai][bj][m][1];
                    float o[8];
                    o[0] = sigmoid_f(bf_lo(g.x)) * a0[0]; o[1] = sigmoid_f(bf_hi(g.x)) * a0[1]; o[2] = sigmoid_f(bf_lo(g.y)) * a0[2]; o[3] = sigmoid_f(bf_hi(g.y)) * a0[3];
                    o[4] = sigmoid_f(bf_lo(g.z)) * a1[0]; o[5] = sigmoid_f(bf_hi(g.z)) * a1[1]; o[6] = sigmoid_f(bf_lo(g.w)) * a1[2]; o[7] = sigmoid_f(bf_hi(g.w)) * a1[3];
                    bf16_t* tp = T + r * ldt + c;
                    if (MODE == 1) { const u32x4 p = *(const u32x4*)tp;
                        o[0] += bf_lo(p.x); o[1] += bf_hi(p.x); o[2] += bf_lo(p.y); o[3] += bf_hi(p.y); o[4] += bf_lo(p.z); o[5] += bf_hi(p.z); o[6] += bf_lo(p.w); o[7] += bf_hi(p.w); }
                    u32x4 w; w.x = cvt_pk_bf16(o[0], o[1]); w.y = cvt_pk_bf16(o[2], o[3]); w.z = cvt_pk_bf16(o[4], o[5]); w.w = cvt_pk_bf16(o[6], o[7]);
                    *(u32x4*)tp = w; }
                asm volatile("" ::: "memory"); }
    }
};

struct EpiInProj {
    static constexpr bool PERM = true, HAS_MID = false, HAS_SEG = false; static constexpr bool HAS_PRE = true; static constexpr int NVM = 8;
    bf16_t* P; bf16_t* KB; bf16_t* VB; const float* qw; const float* kw; const float* rs; const float* cs; PG8_LAS unsigned char* ost0; PG8_LAS unsigned char* scl;
    __device__ __forceinline__ void pre(const Unit& u, int par, int wid, int lane) const {
        const unsigned dst = (unsigned)(__SIZE_TYPE__)scl + (unsigned)par * 2048u + (unsigned)wid * 256u;
        if (wid < 4) glds4_s(rs, (unsigned)(u.pm * BM + 64 * wid + lane) * 4u, dst); else glds4_s(cs, (unsigned)(u.pn * BM + 64 * (wid - 4) + lane) * 4u, dst);
    }
    __device__ __forceinline__ void operator()(const f32x4 (&acc_)[2][2][4][2], const Unit& u, int wr, int wc, int fr, int fq) const {
        const int t = u.pn; const int rowt = u.pm * BM + wr * 64; const int lane = fq * 16 + fr; PG8_LAS unsigned char* ost = ost0 + (wr * 4 + wc) * 2048;
        const PG8_LAS float* rsL = (const PG8_LAS float*)(scl + u.lt * 2048); const PG8_LAS float* csL = rsL + 256;
        float rsv[2][4]; f32x4 csv[2][2];
#pragma unroll
        for (int a = 0; a < 2; ++a)
#pragma unroll
            for (int m = 0; m < 4; ++m) rsv[a][m] = rsL[wr * 64 + a * HALF + m * 16 + fr];
#pragma unroll
        for (int b = 0; b < 2; ++b)
#pragma unroll
            for (int n = 0; n < 2; ++n) csv[b][n] = *(const PG8_LAS f32x4*)(csL + b * HALF + wc * 32 + 8 * fq + 4 * n);
        if (t >= 12) {
#pragma unroll
            for (int b = 0; b < 2; ++b)
#pragma unroll
                for (int n = 0; n < 2; ++n) csv[b][n] = csv[b][n] * -1.4426950408889634f; }
#define ACC(a, b, m, n) (__builtin_convertvector(__builtin_bit_cast(v4i_t, acc_[a][b][m][n]), f32x4) * (csv[b][n] * rsv[a][m]))
        if (t < 4) {
            unsigned char* dst = (unsigned char*)(P + PC_U + 128 * t + wc * 32);
#pragma unroll
            for (int ai = 0; ai < 2; ++ai)
#pragma unroll
                for (int m = 0; m < 4; ++m) { const f32x4 a0 = ACC(ai, 0, m, 0) * ACC(ai, 1, m, 0), a1 = ACC(ai, 0, m, 1) * ACC(ai, 1, m, 1);
                    u32x4 w; w.x = cvt_pk_bf16(a0[0], a0[1]); w.y = cvt_pk_bf16(a0[2], a0[3]); w.z = cvt_pk_bf16(a1[0], a1[1]); w.w = cvt_pk_bf16(a1[2], a1[3]);
                    store_rows32(dst + (size_t)(rowt + ai * HALF + m * 16) * (PP * 2), (size_t)PP * 2, fr, fq, w, ost, lane); }
        } else if (t >= 12) {
            unsigned char* dst = (unsigned char*)P + (t < 16 ? PC_GC * 2 + 256 * (t - 12) : PC_GA * 2 + 256 * (t - 16)) + wc * 64;
#pragma unroll
            for (int ai = 0; ai < 2; ++ai)
#pragma unroll
                for (int m = 0; m < 4; ++m) { const f32x4 c0 = ACC(ai, 0, m, 0), c1 = ACC(ai, 0, m, 1), a0 = ACC(ai, 1, m, 0), a1 = ACC(ai, 1, m, 1);
                    *(PG8_LAS v2u*)(ost + fr * 64 + (((8 * fq) >> 4 ^ ((fr >> 1) & 3)) << 4) + ((8 * fq) & 15)) = (v2u){pk4_fp8(c0[0], c0[1], c0[2], c0[3]), pk4_fp8(c1[0], c1[1], c1[2], c1[3])};
                    *(PG8_LAS v2u*)(ost + fr * 64 + ((((32 + 8 * fq) >> 4) ^ ((fr >> 1) & 3)) << 4) + ((8 * fq) & 15)) = (v2u){pk4_fp8(a0[0], a0[1], a0[2], a0[3]), pk4_fp8(a1[0], a1[1], a1[2], a1[3])};
                    asm volatile("s_waitcnt lgkmcnt(0)" ::: "memory");
                    const int r = lane >> 2, c = lane & 3;
                    const u32x4 a = *(const PG8_LAS u32x4*)(ost + r * 64 + ((c ^ ((r >> 1) & 3)) << 4));
                    asm volatile("s_waitcnt lgkmcnt(0)" ::: "memory");
                    *(u32x4*)(dst + (size_t)(rowt + ai * HALF + m * 16 + r) * (PP * 2) + 16 * c) = a; }
        } else if (t >= 6 && t < 10) {
            const bool isq = t < 8; const int head = 4 * (isq ? t - 6 : t - 8) + wc; const float* nwp = isq ? qw : kw;
            const float sc = isq ? 0.125f * 1.4426950408889634f : 1.0f;
            f32x4 nw[2][2];
#pragma unroll
            for (int bj = 0; bj < 2; ++bj)
#pragma unroll
                for (int n = 0; n < 2; ++n) nw[bj][n] = *(const f32x4*)(nwp + 32 * bj + 8 * fq + 4 * n) * sc;
            const int bq = u.pm / 16, tq = (u.pm % 16) * BM + wr * 64;
            bf16_t* dst = isq ? P + (size_t)rowt * PP + PC_Q + head * 64 : KB + ((size_t)(bq * 8 + head) * 4096 + tq) * 64; const size_t ldd = isq ? (size_t)PP : 64;
#pragma unroll
            for (int ai = 0; ai < 2; ++ai)
#pragma unroll
                for (int m = 0; m < 4; ++m) { float ss = 0.f;
#pragma unroll
                    for (int bj = 0; bj < 2; ++bj)
#pragma unroll
                        for (int n = 0; n < 2; ++n) { const f32x4 v = ACC(ai, bj, m, n); ss += (v[0] * v[0] + v[1] * v[1]) + (v[2] * v[2] + v[3] * v[3]); }
                    { const auto a_ = __builtin_amdgcn_permlane32_swap(__float_as_uint(ss), __float_as_uint(ss), false, false); ss = __uint_as_float(a_[0]) + __uint_as_float(a_[1]);
                      const auto b_ = __builtin_amdgcn_permlane16_swap(__float_as_uint(ss), __float_as_uint(ss), false, false); ss = __uint_as_float(b_[0]) + __uint_as_float(b_[1]); }
                    const float rs = 1.0f / sqrtf(ss * (1.0f / 64.0f) + 1e-6f);
                    u32x4 w[2];
#pragma unroll
                    for (int bj = 0; bj < 2; ++bj) { const f32x4 v0 = ACC(ai, bj, m, 0) * rs * nw[bj][0], v1 = ACC(ai, bj, m, 1) * rs * nw[bj][1];
                        w[bj].x = cvt_pk_bf16(v0[0], v0[1]); w[bj].y = cvt_pk_bf16(v0[2], v0[3]); w[bj].z = cvt_pk_bf16(v1[0], v1[1]); w[bj].w = cvt_pk_bf16(v1[2], v1[3]); }
                    store_rows64(dst + (size_t)(ai * HALF + m * 16) * ldd, ldd, fr, fq, w[0], w[1], ost, lane); }
        } else {
            const int bq = u.pm / 16, tq = (u.pm % 16) * BM + wr * 64;
            bf16_t* dst = t < 6 ? P + (size_t)rowt * PP + PC_B + 256 * (t - 4) + wc * 64 : VB + ((size_t)(bq * 8 + 4 * (t - 10) + wc) * 4096 + tq) * 64; const size_t ldd = t < 6 ? (size_t)PP : 64;
#pragma unroll
            for (int ai = 0; ai < 2; ++ai)
#pragma unroll
                for (int m = 0; m < 4; ++m) { u32x4 w[2];
#pragma unroll
                    for (int bj = 0; bj < 2; ++bj) { const f32x4 v0 = ACC(ai, bj, m, 0), v1 = ACC(ai, bj, m, 1);
                        w[bj].x = cvt_pk_bf16(v0[0], v0[1]); w[bj].y = cvt_pk_bf16(v0[2], v0[3]); w[bj].z = cvt_pk_bf16(v1[0], v1[1]); w[bj].w = cvt_pk_bf16(v1[2], v1[3]); }
                    store_rows64(dst + (size_t)(ai * HALF + m * 16) * ldd, ldd, fr, fq, w[0], w[1], ost, lane); }
        }
#undef ACC
    }
};
struct EpiMerge {
    static constexpr bool PERM = true, HAS_MID = true, HAS_SEG = false; static constexpr bool HAS_PRE = false; static constexpr int NVM = 0;
    const bf16_t* P; unsigned char* T; signed char* EX; PG8_LAS unsigned char* ost; PG8_LAS unsigned char* rowmax;
    typedef float f32x2m __attribute__((ext_vector_type(2)));
    static __device__ __forceinline__ void dec8(const v2u w, float (&o)[8]) {
        const f32x2m a = __builtin_amdgcn_cvt_pk_f32_fp8((int)w.x, false), b = __builtin_amdgcn_cvt_pk_f32_fp8((int)w.x, true), c = __builtin_amdgcn_cvt_pk_f32_fp8((int)w.y, false), d = __builtin_amdgcn_cvt_pk_f32_fp8((int)w.y, true);
        o[0] = a.x; o[1] = a.y; o[2] = b.x; o[3] = b.y; o[4] = c.x; o[5] = c.y; o[6] = d.x; o[7] = d.y; }
    __device__ __forceinline__ void gate_to_lds(PG8_LAS unsigned char* blk, u32x4 v, int lane) const { const int r = lane >> 2, c = lane & 3; *(PG8_LAS u32x4*)(blk + r * 64 + ((c ^ ((r >> 1) & 3)) << 4)) = v; }
    __device__ __forceinline__ v2u gate_from_lds(const PG8_LAS unsigned char* blk, int fr, int byte0) const { return *(const PG8_LAS v2u*)(blk + fr * 64 + (((byte0 >> 4) ^ ((fr >> 1) & 3)) << 4) + (byte0 & 15)); }
    __device__ __forceinline__ void mid(f32x4 (&acc)[2][2][4][2], const Unit& u, int wr, int wc, int fr, int fq) const {
        const int lane = fq * 16 + fr, r = lane >> 2, c = lane & 3; PG8_LAS unsigned char* blk = ost + (wr * 4 + wc) * 2048;
        const unsigned char* gp = (const unsigned char*)(P + (size_t)(u.pm * BM + wr * 64 + r) * PP) + u.pn * BM + wc * 64 + 16 * c;
        u32x4 gc[2][4], ga[2][4];
#pragma unroll
        for (int ai = 0; ai < 2; ++ai)
#pragma unroll
            for (int m = 0; m < 4; ++m) { const unsigned char* rp = gp + (size_t)(ai * HALF + m * 16) * (PP * 2); gc[ai][m] = *(const u32x4*)(rp + PC_GC * 2); ga[ai][m] = *(const u32x4*)(rp + PC_GA * 2); }
#pragma unroll
        for (int ai = 0; ai < 2; ++ai)
#pragma unroll
            for (int m = 0; m < 4; ++m) { gate_to_lds(blk, gc[ai][m], lane); gate_to_lds(blk + 1024, ga[ai][m], lane);
                asm volatile("s_waitcnt lgkmcnt(0)" ::: "memory");
                v2u c2[2], a2[2];
#pragma unroll
                for (int bj = 0; bj < 2; ++bj) { c2[bj] = gate_from_lds(blk, fr, 32 * bj + 8 * fq); a2[bj] = gate_from_lds(blk + 1024, fr, 32 * bj + 8 * fq); }
                asm volatile("s_waitcnt lgkmcnt(0)" ::: "memory");
#pragma unroll
                for (int bj = 0; bj < 2; ++bj) { float cc[8], aa[8]; dec8(c2[bj], cc); dec8(a2[bj], aa);
#pragma unroll
                    for (int i = 0; i < 8; ++i) { const float ec = __builtin_amdgcn_exp2f(cc[i]), ea = __builtin_amdgcn_exp2f(aa[i]);
                        acc[ai][bj][m][i >> 2][i & 3] *= (1.0f + ea) * __builtin_amdgcn_rcpf(1.0f + ec); } } }
    }
    __device__ __forceinline__ void operator()(f32x4 (&acc)[2][2][4][2], const Unit& u, int wr, int wc, int fr, int fq) const {
        const int rowt = u.pm * BM + wr * 64, colw = u.pn * BM + wc * 64; const int lane = fq * 16 + fr, r = lane >> 2, c = lane & 3; PG8_LAS unsigned char* blk = ost + (wr * 4 + wc) * 2048;
        const unsigned char* gp = (const unsigned char*)(P + (size_t)(rowt + r) * PP) + colw + 16 * c + PC_GA * 2;
        u32x4 gaa[2][4];
#pragma unroll
        for (int ai = 0; ai < 2; ++ai)
#pragma unroll
            for (int m = 0; m < 4; ++m) gaa[ai][m] = *(const u32x4*)(gp + (size_t)(ai * HALF + m * 16) * (PP * 2));
        PG8_LAS float* rmx = (PG8_LAS float*)(rowmax);
#pragma unroll
        for (int ai = 0; ai < 2; ++ai)
#pragma unroll
            for (int m = 0; m < 4; ++m) {
                gate_to_lds(blk + 1024, gaa[ai][m], lane);
                asm volatile("s_waitcnt lgkmcnt(0)" ::: "memory");
                v2u a2[2];
#pragma unroll
                for (int bj = 0; bj < 2; ++bj) a2[bj] = gate_from_lds(blk + 1024, fr, 32 * bj + 8 * fq);
                asm volatile("s_waitcnt lgkmcnt(0)" ::: "memory");
                float mx = 0.f;
#pragma unroll
                for (int bj = 0; bj < 2; ++bj) { float a[8]; dec8(a2[bj], a);
#pragma unroll
                    for (int i = 0; i < 8; ++i) { const float v = acc[ai][bj][m][i >> 2][i & 3] * __builtin_amdgcn_rcpf(1.0f + __builtin_amdgcn_exp2f(a[i])); acc[ai][bj][m][i >> 2][i & 3] = v; mx = fmaxf(mx, fabsf(v)); } }
                { const auto p_ = __builtin_amdgcn_permlane32_swap(__float_as_uint(mx), __float_as_uint(mx), false, false); mx = fmaxf(__uint_as_float(p_[0]), __uint_as_float(p_[1]));
                  const auto q_ = __builtin_amdgcn_permlane16_swap(__float_as_uint(mx), __float_as_uint(mx), false, false); mx = fmaxf(__uint_as_float(q_[0]), __uint_as_float(q_[1])); }
                if (fq == 0) rmx[(ai * HALF + wr * 64 + m * 16 + fr) * 4 + wc] = mx; }
        asm volatile("s_waitcnt lgkmcnt(0)" ::: "memory"); __builtin_amdgcn_s_barrier(); asm volatile("" ::: "memory");
#pragma unroll
        for (int ai = 0; ai < 2; ++ai)
#pragma unroll
            for (int m = 0; m < 4; ++m) { const int rl = ai * HALF + wr * 64 + m * 16 + fr;
                const f32x4 q4 = *(const PG8_LAS f32x4*)(rmx + rl * 4); const float mx = fmaxf(fmaxf(q4[0], q4[1]), fmaxf(q4[2], q4[3]));
                int ex; const float fm = __builtin_frexpf(mx, &ex);
                const int e = mx > 0.f ? (fm <= 0.9921875f ? ex - 7 : ex - 6) : 0;
                const float inv = __builtin_ldexpf(1.0f, -e);
                v2u w[2];
#pragma unroll
                for (int bj = 0; bj < 2; ++bj) { const f32x4 v0 = acc[ai][bj][m][0] * inv, v1 = acc[ai][bj][m][1] * inv; w[bj].x = pk4_i8(v0[0], v0[1], v0[2], v0[3]); w[bj].y = pk4_i8(v1[0], v1[1], v1[2], v1[3]); }
                store_rows32_2x8(T + (size_t)(rowt + ai * HALF + m * 16) * 1024 + colw, 1024, fr, fq, w[0], w[1], blk, lane);
                if (wc == 0 && fq == 0) EX[(size_t)(u.pm * BM + rl) * 4 + u.pn] = (signed char)e; }
    }
};

struct EpiNull {
    static constexpr bool PERM = true, HAS_MID = false, HAS_SEG = false; static constexpr bool HAS_PRE = false; static constexpr int NVM = 0;
    __device__ __forceinline__ void operator()(const f32x4 (&acc)[2][2][4][2], const Unit&, int, int, int, int) const {
#pragma unroll
        for (int a = 0; a < 2; ++a)
#pragma unroll
            for (int b = 0; b < 2; ++b)
#pragma unroll
                for (int m = 0; m < 4; ++m)
#pragma unroll
                    for (int n = 0; n < 2; ++n) asm volatile("" :: "v"(acc[a][b][m][n]));
    }
};

struct EpiDelta {
    static constexpr bool PERM = true, HAS_MID = false, HAS_SEG = false; static constexpr bool HAS_PRE = false; static constexpr int NVM = 0;
    const float* mod; const float* X; bf16_t* T; float ascale; PG8_LAS unsigned char* ost0;
    __device__ __forceinline__ void operator()(const f32x4 (&acc)[2][2][4][2], const Unit& u, int wr, int wc, int fr, int fq) const {
        const int rowt = u.pm * BM + wr * 64, colw = u.pn * BM + wc * 64; PG8_LAS unsigned char* ost = ost0 + (wr * 4 + wc) * 2048;
        const int lane = fq * 16 + fr, r = lane >> 3, c = lane & 7;
        const float* gate = mod + (size_t)(u.pm / 16) * 6144 + 2048;
        f32x4 gv[2][2];
#pragma unroll
        for (int bj = 0; bj < 2; ++bj)
#pragma unroll
            for (int n = 0; n < 2; ++n) gv[bj][n] = *(const f32x4*)(gate + colw + 32 * bj + 8 * fq + 4 * n) * ascale;
#pragma unroll
        for (int ai = 0; ai < 2; ++ai) { f32x4 xs[4][2][2];
#pragma unroll
            for (int m = 0; m < 4; ++m)
#pragma unroll
                for (int h = 0; h < 2; ++h) { const float* xp = X + (size_t)(rowt + ai * HALF + m * 16 + r + 8 * h) * 1024 + colw + 8 * c; xs[m][h][0] = *(const f32x4*)xp; xs[m][h][1] = *(const f32x4*)(xp + 4); }
#pragma unroll
            for (int m = 0; m < 4; ++m) { u32x4 w[2];
#pragma unroll
                for (int bj = 0; bj < 2; ++bj) { const f32x4 v0 = acc[ai][bj][m][0] * gv[bj][0], v1 = acc[ai][bj][m][1] * gv[bj][1];
                    w[bj].x = cvt_pk_bf16(v0[0], v0[1]); w[bj].y = cvt_pk_bf16(v0[2], v0[3]); w[bj].z = cvt_pk_bf16(v1[0], v1[1]); w[bj].w = cvt_pk_bf16(v1[2], v1[3]); }
                *(PG8_LAS u32x4*)(ost + fr * 128 + ((fq ^ (fr & 7)) << 4)) = w[0]; *(PG8_LAS u32x4*)(ost + fr * 128 + (((fq + 4) ^ (fr & 7)) << 4)) = w[1];
                asm volatile("s_waitcnt lgkmcnt(0)" ::: "memory");
                const u32x4 a = *(const PG8_LAS u32x4*)(ost + r * 128 + ((c ^ (r & 7)) << 4)), b = *(const PG8_LAS u32x4*)(ost + (r + 8) * 128 + ((c ^ (r & 7)) << 4));
                asm volatile("s_waitcnt lgkmcnt(0)" ::: "memory");
                bf16_t* tp = T + (size_t)(rowt + ai * HALF + m * 16 + r) * 1024 + colw + 8 * c;
                { const f32x4 x0 = xs[m][0][0], x1 = xs[m][0][1]; u32x4 o; o.x = cvt_pk_bf16(x0[0] + bf_lo(a.x), x0[1] + bf_hi(a.x)); o.y = cvt_pk_bf16(x0[2] + bf_lo(a.y), x0[3] + bf_hi(a.y)); o.z = cvt_pk_bf16(x1[0] + bf_lo(a.z), x1[1] + bf_hi(a.z)); o.w = cvt_pk_bf16(x1[2] + bf_lo(a.w), x1[3] + bf_hi(a.w)); *(u32x4*)tp = o; }
                { const f32x4 x0 = xs[m][1][0], x1 = xs[m][1][1]; u32x4 o; o.x = cvt_pk_bf16(x0[0] + bf_lo(b.x), x0[1] + bf_hi(b.x)); o.y = cvt_pk_bf16(x0[2] + bf_lo(b.y), x0[3] + bf_hi(b.y)); o.z = cvt_pk_bf16(x1[0] + bf_lo(b.z), x1[1] + bf_hi(b.z)); o.w = cvt_pk_bf16(x1[2] + bf_lo(b.w), x1[3] + bf_hi(b.w)); *(u32x4*)(tp + 8 * 1024) = o; } }
            asm volatile("" ::: "memory"); }
    }
};
struct EpiDelta8 {
    static constexpr bool PERM = true, HAS_MID = false, HAS_SEG = true; static constexpr bool HAS_PRE = false; static constexpr int NVM = 0;
    const float* mod; const float* X; bf16_t* T; const signed char* EX; const float* cs; PG8_LAS unsigned char* ost0;
    __device__ __forceinline__ void seg_fetch(const Unit& u, int wr, int wc, int fr, int fq) const {
        const unsigned ldsb = (unsigned)(__SIZE_TYPE__)(ost0 + (wr * 4 + wc) * 2048);
#pragma unroll
        for (int j = 0; j < 8; ++j) glds4_s(EX, (unsigned)(u.pm * BM + wr * 64 + fr + (j >> 2) * HALF + (j & 3) * 16) * 4u, ldsb + 256u * j);
    }
    __device__ __forceinline__ void seg(f32x4 (&acc)[2][2][4][2], const Unit& u, int sg, int wr, int wc, int fr, int fq) const {
        PG8_LAS unsigned char* blk = ost0 + (wr * 4 + wc) * 2048; const int lane = fq * 16 + fr;
#pragma unroll
        for (int ai = 0; ai < 2; ++ai)
#pragma unroll
            for (int m = 0; m < 4; ++m) { const unsigned wd = *(const PG8_LAS unsigned*)(blk + 256 * (ai * 4 + m) + 4 * lane);
                const int ec = (int)(signed char)((wd >> (8 * sg)) & 0xffu), ep = (int)(signed char)((wd >> (8 * sg - 8)) & 0xffu); const int d = ec - ep;
                const int sr = d > 0 ? d : 0, sl = d < 0 ? -d : 0;
#pragma unroll
                for (int bj = 0; bj < 2; ++bj)
#pragma unroll
                    for (int n = 0; n < 2; ++n) { v4i_t a = __builtin_bit_cast(v4i_t, acc[ai][bj][m][n]); a = (a >> sr) << sl; acc[ai][bj][m][n] = __builtin_bit_cast(f32x4, a); } }
    }
    __device__ __forceinline__ void operator()(const f32x4 (&acc)[2][2][4][2], const Unit& u, int wr, int wc, int fr, int fq) const {
        const int rowt = u.pm * BM + wr * 64, colw = u.pn * BM + wc * 64; PG8_LAS unsigned char* ost = ost0 + (wr * 4 + wc) * 2048;
        const int lane = fq * 16 + fr, r = lane >> 3, c = lane & 7;
        unsigned st[8];
#pragma unroll
        for (int j = 0; j < 8; ++j) st[j] = *(const PG8_LAS unsigned*)(ost + 256 * j + 4 * lane);
        asm volatile("s_waitcnt lgkmcnt(0)" ::: "memory");
        const float* gate = mod + (size_t)(u.pm / 16) * 6144 + 2048;
        f32x4 gv[2][2];
#pragma unroll
        for (int bj = 0; bj < 2; ++bj)
#pragma unroll
            for (int n = 0; n < 2; ++n) gv[bj][n] = *(const f32x4*)(gate + colw + 32 * bj + 8 * fq + 4 * n) * *(const f32x4*)(cs + u.pn * BM + bj * HALF + wc * 32 + 8 * fq + 4 * n);
#pragma unroll
        for (int ai = 0; ai < 2; ++ai) { f32x4 xs[4][2][2];
#pragma unroll
            for (int m = 0; m < 4; ++m)
#pragma unroll
                for (int h = 0; h < 2; ++h) { const float* xp = X + (size_t)(rowt + ai * HALF + m * 16 + r + 8 * h) * 1024 + colw + 8 * c; xs[m][h][0] = *(const f32x4*)xp; xs[m][h][1] = *(const f32x4*)(xp + 4); }
#pragma unroll
            for (int m = 0; m < 4; ++m) { u32x4 w[2];
                const float rsc = __builtin_ldexpf(1.0f, (int)(signed char)(st[ai * 4 + m] >> 24));
#pragma unroll
                for (int bj = 0; bj < 2; ++bj) { const f32x4 v0 = __builtin_convertvector(__builtin_bit_cast(v4i_t, acc[ai][bj][m][0]), f32x4) * (gv[bj][0] * rsc), v1 = __builtin_convertvector(__builtin_bit_cast(v4i_t, acc[ai][bj][m][1]), f32x4) * (gv[bj][1] * rsc);
                    w[bj].x = cvt_pk_bf16(v0[0], v0[1]); w[bj].y = cvt_pk_bf16(v0[2], v0[3]); w[bj].z = cvt_pk_bf16(v1[0], v1[1]); w[bj].w = cvt_pk_bf16(v1[2], v1[3]); }
                *(PG8_LAS u32x4*)(ost + fr * 128 + ((fq ^ (fr & 7)) << 4)) = w[0]; *(PG8_LAS u32x4*)(ost + fr * 128 + (((fq + 4) ^ (fr & 7)) << 4)) = w[1];
                asm volatile("s_waitcnt lgkmcnt(0)" ::: "memory");
                const u32x4 a = *(const PG8_LAS u32x4*)(ost + r * 128 + ((c ^ (r & 7)) << 4)), b = *(const PG8_LAS u32x4*)(ost + (r + 8) * 128 + ((c ^ (r & 7)) << 4));
                asm volatile("s_waitcnt lgkmcnt(0)" ::: "memory");
                bf16_t* tp = T + (size_t)(rowt + ai * HALF + m * 16 + r) * 1024 + colw + 8 * c;
                { const f32x4 x0 = xs[m][0][0], x1 = xs[m][0][1]; u32x4 o; o.x = cvt_pk_bf16(x0[0] + bf_lo(a.x), x0[1] + bf_hi(a.x)); o.y = cvt_pk_bf16(x0[2] + bf_lo(a.y), x0[3] + bf_hi(a.y)); o.z = cvt_pk_bf16(x1[0] + bf_lo(a.z), x1[1] + bf_hi(a.z)); o.w = cvt_pk_bf16(x1[2] + bf_lo(a.w), x1[3] + bf_hi(a.w)); *(u32x4*)tp = o; }
                { const f32x4 x0 = xs[m][1][0], x1 = xs[m][1][1]; u32x4 o; o.x = cvt_pk_bf16(x0[0] + bf_lo(b.x), x0[1] + bf_hi(b.x)); o.y = cvt_pk_bf16(x0[2] + bf_lo(b.y), x0[3] + bf_hi(b.y)); o.z = cvt_pk_bf16(x1[0] + bf_lo(b.z), x1[1] + bf_hi(b.z)); o.w = cvt_pk_bf16(x1[2] + bf_lo(b.w), x1[3] + bf_hi(b.w)); *(u32x4*)(tp + 8 * 1024) = o; } }
            asm volatile("" ::: "memory"); }
    }
};
struct EpiResid {
    static constexpr bool PERM = false, HAS_MID = false, HAS_SEG = false; static constexpr bool HAS_PRE = false; static constexpr int NVM = 0;
    const float* X; const float* mod; float* out; int ldc;
    __device__ __forceinline__ void operator()(const f32x4 (&acc)[2][2][4][2], const Unit& u, int wr, int wc, int fr, int fq) const {
        const int row0 = u.pm * BM + wr * 64 + fr, col0 = u.pn * BM + wc * 32 + 4 * fq;
        const float* gate = mod + (size_t)(u.pm / 16) * 6144 + 2048;
        f32x4 gv[2][2];
#pragma unroll
        for (int bj = 0; bj < 2; ++bj)
#pragma unroll
            for (int n = 0; n < 2; ++n) gv[bj][n] = *(const f32x4*)(gate + col0 + bj * HALF + n * 16);
#pragma unroll
        for (int ai = 0; ai < 2; ++ai) { f32x4 xs[4][2][2];
#pragma unroll
            for (int m = 0; m < 4; ++m) { const size_t off = (size_t)(row0 + ai * HALF + m * 16) * ldc + col0;
#pragma unroll
                for (int bj = 0; bj < 2; ++bj)
#pragma unroll
                    for (int n = 0; n < 2; ++n) xs[m][bj][n] = *(const f32x4*)(X + off + bj * HALF + n * 16); }
#pragma unroll
            for (int m = 0; m < 4; ++m) { const size_t off = (size_t)(row0 + ai * HALF + m * 16) * ldc + col0;
#pragma unroll
                for (int bj = 0; bj < 2; ++bj)
#pragma unroll
                    for (int n = 0; n < 2; ++n) *(f32x4*)(out + off + bj * HALF + n * 16) = xs[m][bj][n] + gv[bj][n] * acc[ai][bj][m][n]; }
            asm volatile("" ::: "memory"); }
    }
};
struct EpiLogits {
    static constexpr bool PERM = false, HAS_MID = false, HAS_SEG = false; static constexpr bool HAS_PRE = false; static constexpr int NVM = 0;
    float* L; int ldl, ncols; const PG8_LAS float* rs2;
    __device__ __forceinline__ void operator()(const f32x4 (&acc)[2][2][4][2], const Unit& u, int wr, int wc, int fr, int fq) const {
        const int row0 = u.pm * BM + wr * 64 + fr;
#pragma unroll
        for (int n = 0; n < 2; ++n) { const int c = wc * 32 + n * 16 + 4 * fq;
            if (c < ncols) {
#pragma unroll
                for (int ai = 0; ai < 2; ++ai)
#pragma unroll
                    for (int m = 0; m < 4; ++m) *(f32x4*)(L + (size_t)(row0 + ai * HALF + m * 16) * ldl + c) = acc[ai][0][m][n] * rs2[wr * 64 + fr + ai * HALF + m * 16]; } }
    }
};
struct EpiGLU {
    static constexpr bool PERM = true, HAS_MID = false, HAS_SEG = false; static constexpr bool HAS_PRE = false; static constexpr int NVM = 0;
    unsigned char* ACT; const float* WL; float ascale; PG8_LAS unsigned char* ost0;
    __device__ __forceinline__ void operator()(const f32x4 (&acc)[2][2][4][2], const Unit& u, int wr, int wc, int fr, int fq) const {
        const int rl0 = wr * 64 + fr;
        unsigned char* dst = ACT + (size_t)(u.pm * BM + wr * 64) * 256 + u.pn * HALF + wc * 32;
#pragma unroll
        for (int ai = 0; ai < 2; ++ai)
#pragma unroll
            for (int m = 0; m < 4; ++m) { const int rl = rl0 + ai * HALF + m * 16; const int p = u.lt * BM + rl;
                int pi = p < 65536 ? p : 65535; asm volatile("" : "+v"(pi));
                const float wv = WL[(size_t)u.e * 65536 + pi]; const float w = p < u.cnt ? wv * A8_SCALE : 0.f;
                const f32x4 g0 = acc[ai][0][m][0] * ascale, g1 = acc[ai][0][m][1] * ascale, u0 = acc[ai][1][m][0] * ascale, u1 = acc[ai][1][m][1] * ascale;
                float o[8];
#pragma unroll
                for (int i = 0; i < 4; ++i) { o[i] = g0[i] * sigmoid_f(g0[i]) * u0[i] * w; o[4 + i] = g1[i] * sigmoid_f(g1[i]) * u1[i] * w; }
                int ro = (ai * HALF + m * 16 + fr) * 256 + 8 * fq; asm volatile("" : "+v"(ro));
                *(v2u*)(dst + ro) = (v2u){pk4_fp8(o[0], o[1], o[2], o[3]), pk4_fp8(o[4], o[5], o[6], o[7])};
                asm volatile("" ::: "memory"); }
    }
};
template <int SUB, size_t a_tstep, size_t b_estep, size_t b_tstep> struct MoeSched {
    const char* A; const char* Bt; const int* list; const PG8_LAS int* tab; int G, c;
    __device__ __forceinline__ bool next(int i, Unit& u) const {
        int z_ = 0; asm volatile("" : "+v"(z_)); const PG8_LAS int* tab = this->tab + z_;
        const int L = i * G + c, T = L / SUB; const int ttot = __builtin_amdgcn_readfirstlane(tab[32]);
        if (T >= ttot) return false;
        const int e = __builtin_amdgcn_readfirstlane(tab[256 + T]);
        u.pm = __builtin_amdgcn_readfirstlane(T); u.pn = __builtin_amdgcn_readfirstlane(L % SUB); u.e = __builtin_amdgcn_readfirstlane(e); u.lt = T - __builtin_amdgcn_readfirstlane(tab[e]); u.cnt = __builtin_amdgcn_readfirstlane(tab[64 + e]); return true;
    }
    __device__ __forceinline__ const char* a_base(const Unit& u) const { return A + (size_t)u.pm * a_tstep; }
    __device__ __forceinline__ const char* b_base(const Unit& u) const { return Bt + (size_t)u.e * b_estep + (size_t)u.pn * b_tstep; }
    __device__ __forceinline__ void ids_dma(const Unit& u, int r, unsigned lds_dst) const { const int p = u.lt * BM + r; glds4_s(list, ((unsigned)u.e * 65536u + (unsigned)(p < 65536 ? p : 65535)) * 4u, lds_dst); }
    __device__ __forceinline__ int row_pick(const Unit& u, int r, int v) const { return u.lt * BM + r < u.cnt ? v : 0; }
    __device__ __forceinline__ int row_index(const Unit& u, int r) const { const int p = u.lt * BM + r; const int v = list[(size_t)u.e * 65536 + (p < 65536 ? p : 65535)]; return p < u.cnt ? v : 0; }
};
}
struct Frame {
    LAS unsigned char* lds;
    volatile LAS unsigned* MISC;
    gu32* ctl;
    int wave;
    int vcu, G;
    const LAS unsigned long long* ptab;
    float* out; unsigned char* ws;
};
__device__ __forceinline__ const float* inp(const Frame& F, int k) { const unsigned long long v = F.ptab[k]; const unsigned lo = __builtin_amdgcn_readfirstlane((unsigned)v), hi = __builtin_amdgcn_readfirstlane((unsigned)(v >> 32)); return (const float*)(const GAS float*)(((unsigned long long)hi << 32) | lo); }
__device__ __forceinline__ float wave_sum(float v) {
    { const auto a = __builtin_amdgcn_permlane32_swap(__float_as_uint(v), __float_as_uint(v), false, false); v = __uint_as_float(a[0]) + __uint_as_float(a[1]); }
    { const auto a = __builtin_amdgcn_permlane16_swap(__float_as_uint(v), __float_as_uint(v), false, false); v = __uint_as_float(a[0]) + __uint_as_float(a[1]); }
    v += __uint_as_float((unsigned)__builtin_amdgcn_update_dpp(0, (int)__float_as_uint(v), 0x128, 0xf, 0xf, false));
    v += __uint_as_float((unsigned)__builtin_amdgcn_update_dpp(0, (int)__float_as_uint(v), 0x124, 0xf, 0xf, false));
    v += __uint_as_float((unsigned)__builtin_amdgcn_update_dpp(0, (int)__float_as_uint(v), 0x122, 0xf, 0xf, false));
    v += __uint_as_float((unsigned)__builtin_amdgcn_update_dpp(0, (int)__float_as_uint(v), 0x121, 0xf, 0xf, false));
    return v;
}
__device__ __forceinline__ float wave_max(float v) {
    { const auto a = __builtin_amdgcn_permlane32_swap(__float_as_uint(v), __float_as_uint(v), false, false); v = fmaxf(__uint_as_float(a[0]), __uint_as_float(a[1])); }
    { const auto a = __builtin_amdgcn_permlane16_swap(__float_as_uint(v), __float_as_uint(v), false, false); v = fmaxf(__uint_as_float(a[0]), __uint_as_float(a[1])); }
    v = fmaxf(v, __uint_as_float((unsigned)__builtin_amdgcn_update_dpp(0, (int)__float_as_uint(v), 0x128, 0xf, 0xf, false)));
    v = fmaxf(v, __uint_as_float((unsigned)__builtin_amdgcn_update_dpp(0, (int)__float_as_uint(v), 0x124, 0xf, 0xf, false)));
    v = fmaxf(v, __uint_as_float((unsigned)__builtin_amdgcn_update_dpp(0, (int)__float_as_uint(v), 0x122, 0xf, 0xf, false)));
    v = fmaxf(v, __uint_as_float((unsigned)__builtin_amdgcn_update_dpp(0, (int)__float_as_uint(v), 0x121, 0xf, 0xf, false)));
    return v;
}
__device__ __forceinline__ void cmax_item(const float* src, int ldw, unsigned* cmax, int lane) {
    f32x4 m = {0.f, 0.f, 0.f, 0.f};
#pragma unroll
    for (int i = 0; i < 8; ++i) { const f32x4 t = *(const f32x4*)(src + (size_t)(8 * i + (lane >> 3)) * ldw + 4 * (lane & 7)); m.x = fmaxf(m.x, fabsf(t.x)); m.y = fmaxf(m.y, fabsf(t.y)); m.z = fmaxf(m.z, fabsf(t.z)); m.w = fmaxf(m.w, fabsf(t.w)); }
#pragma unroll
    for (int o = 8; o < 64; o <<= 1) { m.x = fmaxf(m.x, __shfl_xor(m.x, o)); m.y = fmaxf(m.y, __shfl_xor(m.y, o)); m.z = fmaxf(m.z, __shfl_xor(m.z, o)); m.w = fmaxf(m.w, __shfl_xor(m.w, o)); }
    if (lane < 8) { unsigned* c = cmax + 4 * lane;
        __hip_atomic_fetch_max(c + 0, __float_as_uint(m.x), __ATOMIC_RELAXED, __HIP_MEMORY_SCOPE_AGENT); __hip_atomic_fetch_max(c + 1, __float_as_uint(m.y), __ATOMIC_RELAXED, __HIP_MEMORY_SCOPE_AGENT);
        __hip_atomic_fetch_max(c + 2, __float_as_uint(m.z), __ATOMIC_RELAXED, __HIP_MEMORY_SCOPE_AGENT); __hip_atomic_fetch_max(c + 3, __float_as_uint(m.w), __ATOMIC_RELAXED, __HIP_MEMORY_SCOPE_AGENT); }
}
__device__ __forceinline__ void tr_item_q8(const float* src, int ldw, unsigned char* dst, int ldd, const unsigned* cmax, float* cs, LAS float* scr, int lane) {
    { f32x4 t[8];
#pragma unroll
      for (int i = 0; i < 8; ++i) t[i] = *(const f32x4*)(src + (size_t)(8 * i + (lane >> 3)) * ldw + 4 * (lane & 7));
#pragma unroll
      for (int i = 0; i < 8; ++i) { LAS float* d = scr + (8 * i + (lane >> 3)) * 33 + 4 * (lane & 7); d[0] = t[i].x; d[1] = t[i].y; d[2] = t[i].z; d[3] = t[i].w; } }
    LDS_WAIT(); asm volatile("" ::: "memory");
    const int c = lane & 7;
#pragma unroll
    for (int j = 0; j < 4; ++j) { const int n = (lane >> 3) + 8 * j; const LAS float* s = scr + (8 * c) * 33 + n;
        const float mx = __uint_as_float(__hip_atomic_load(cmax + n, __ATOMIC_RELAXED, __HIP_MEMORY_SCOPE_AGENT)); const float inv = mx > 0.f ? 127.0f / mx : 0.f;
        v2u o; o.x = pk4_i8(s[0 * 33] * inv, s[1 * 33] * inv, s[2 * 33] * inv, s[3 * 33] * inv); o.y = pk4_i8(s[4 * 33] * inv, s[5 * 33] * inv, s[6 * 33] * inv, s[7 * 33] * inv);
        *(GAS v2u*)(dst + (size_t)n * ldd + 8 * c) = o;
        if (cs && c == 0) cs[n] = mx * (1.0f / 127.0f); }
    LDS_WAIT(); asm volatile("" ::: "memory");
}
__device__ __forceinline__ void tr_item(const float* src, int ldw, bf16* dst, int ldd, LAS float* scr, int lane) {
    { f32x4 t[8];
#pragma unroll
      for (int i = 0; i < 8; ++i) t[i] = *(const f32x4*)(src + (size_t)(8 * i + (lane >> 3)) * ldw + 4 * (lane & 7));
#pragma unroll
      for (int i = 0; i < 8; ++i) { LAS float* d = scr + (8 * i + (lane >> 3)) * 33 + 4 * (lane & 7); d[0] = t[i].x; d[1] = t[i].y; d[2] = t[i].z; d[3] = t[i].w; } }
    LDS_WAIT(); asm volatile("" ::: "memory");
    const int c = lane & 7;
#pragma unroll
    for (int j = 0; j < 4; ++j) { const int n = (lane >> 3) + 8 * j; const LAS float* s = scr + (8 * c) * 33 + n;
        v4u o; o.x = pk2(s[0 * 33], s[1 * 33]); o.y = pk2(s[2 * 33], s[3 * 33]); o.z = pk2(s[4 * 33], s[5 * 33]); o.w = pk2(s[6 * 33], s[7 * 33]);
        *(GAS v4u*)(dst + (size_t)n * ldd + 8 * c) = o; }
    LDS_WAIT(); asm volatile("" ::: "memory");
}

__device__ __forceinline__ void tr_item8(const float* src, int ldw, unsigned char* dst, int ldd, float scale, LAS float* scr, int lane) {
    { f32x4 t[8];
#pragma unroll
      for (int i = 0; i < 8; ++i) t[i] = *(const f32x4*)(src + (size_t)(8 * i + (lane >> 3)) * ldw + 4 * (lane & 7));
#pragma unroll
      for (int i = 0; i < 8; ++i) { LAS float* d = scr + (8 * i + (lane >> 3)) * 33 + 4 * (lane & 7); d[0] = t[i].x; d[1] = t[i].y; d[2] = t[i].z; d[3] = t[i].w; } }
    LDS_WAIT(); asm volatile("" ::: "memory");
    const int c = lane & 7;
#pragma unroll
    for (int j = 0; j < 4; ++j) { const int n = (lane >> 3) + 8 * j; const LAS float* s = scr + (8 * c) * 33 + n;
        v2u o; o.x = pk4_fp8(s[0 * 33] * scale, s[1 * 33] * scale, s[2 * 33] * scale, s[3 * 33] * scale); o.y = pk4_fp8(s[4 * 33] * scale, s[5 * 33] * scale, s[6 * 33] * scale, s[7 * 33] * scale);
        *(GAS v2u*)(dst + (size_t)n * ldd + 8 * c) = o; }
    LDS_WAIT(); asm volatile("" ::: "memory");
}
#define COL64ROW(n0) ((((n0) >> 8) << 8) + 128 * ((((n0) & 255) >> 5) & 1) + 32 * (((n0) & 255) >> 6))
__device__ __forceinline__ void p0_prologue(Frame& F) {
    const int lane = mk_lane(), tid = F.wave * 64 + lane; (void)tid;
    const float* const in1_ = inp(F, 1);
    const float* const in2_ = inp(F, 2);
    const float* const in5_ = inp(F, 5);
    const float* const in10_ = inp(F, 10);
    const float* const in11_ = inp(F, 11);
    const float* const in12_ = inp(F, 12);
    const float* const in14_ = inp(F, 14);
    const float* const in16_ = inp(F, 16);
    const float* const in18_ = inp(F, 18);
    const float* const in19_ = inp(F, 19);
    const float* const in20_ = inp(F, 20);
    LAS float* scr = (LAS float*)(F.lds + RING_OFF + F.wave * 16384);
    const int gw = F.vcu * NWAVES + F.wave, NGW = F.G * NWAVES;
    bf16* WOC = (bf16*)(F.ws + WS_WOC);
    constexpr int I_IN = 16 * 160, I_OC = 8 * 32, I_O = 16 * 32, I_G = 32 * 128, I_D = 32 * 128;
    constexpr int NITEMS = I_IN + 2 * I_OC + I_O + 2 * I_G;
    for (int it = gw; it < NITEMS; it += NGW) {
        int r = it;
        if (r < I_IN) { const int kb = r / 160, nb = r % 160, n0 = 32 * nb, t = n0 >> 8, rho = n0 & 255; int sc;
            const int c64 = 64 * ((rho >> 5) & 3) + 32 * (rho >> 7);
            if (t < 4) sc = rho < 128 ? 128 * t + rho : 1024 + 128 * t + (rho - 128); else if (t < 6) sc = 512 + 256 * (t - 4) + c64;
            else if (t < 10) sc = (t < 8 ? 1536 : 2048) + 256 * (t < 8 ? t - 6 : t - 8) + c64; else if (t < 12) sc = 2560 + 256 * (t - 10) + c64;
            else if (t < 16) sc = 3080 + 256 * (t - 12) + c64; else sc = 4104 + 256 * (t - 16) + c64;
            cmax_item(in5_ + (size_t)(64 * kb) * INC + sc, INC, (unsigned*)(F.ctl + CW_CMAX) + n0, lane);
            continue; } r -= I_IN;
        if (r < I_OC) { const int kb = r / 32, nb = r % 32; tr_item(in10_ + (size_t)(64 * kb) * 1024 + 32 * nb, 1024, WOC + (size_t)COL64ROW(32 * nb) * 1024 + 64 * kb, 1024, scr, lane); continue; } r -= I_OC;
        if (r < I_OC) { const int kb = r / 32, nb = r % 32; tr_item(in11_ + (size_t)(64 * kb) * 1024 + 32 * nb, 1024, WOC + (size_t)COL64ROW(32 * nb) * 1024 + 512 + 64 * kb, 1024, scr, lane); continue; } r -= I_OC;
        if (r < I_O) { const int kb = r / 32, nb = r % 32; cmax_item(in12_ + (size_t)(64 * kb) * 1024 + 32 * nb, 1024, (unsigned*)(F.ctl + CW_CMAX) + PP5 + COL64ROW(32 * nb), lane); continue; } r -= I_O;
        if (r < 2 * I_G) { const int up = r >= I_G ? 1 : 0; r -= up * I_G; const int e = r / 128, q = r % 128, kb = q / 8, nb = q % 8, j0 = 32 * nb, row = (j0 / 128) * 256 + up * 128 + (j0 % 128);
            tr_item8((up ? in19_ : in18_) + (size_t)e * 1024 * 256 + (size_t)(64 * kb) * 256 + j0, 256, (unsigned char*)(F.ws + WS_WGU) + ((size_t)e * 512 + row) * 1024 + 64 * kb, 1024, W8_SCALE, scr, lane); continue; } r -= 2 * I_G;
    }
    float* MODP = (float*)(F.ws + WS_MODP);
    for (int task = gw; task < 96 * 16; task += NGW) {
        const int cg = task % 96, ks = task / 96, j = cg * 64 + lane, k0 = ks * 64;
#pragma unroll
        for (int b = 0; b < 16; ++b) { const float v = in1_[b * 1024 + k0 + lane]; scr[lane * 16 + b] = v / (1.0f + __expf(-v)); }
        LDS_WAIT(); asm volatile("" ::: "memory");
        float acc[16];
#pragma unroll
        for (int b = 0; b < 16; ++b) acc[b] = 0.f;
#pragma unroll 8
        for (int kk = 0; kk < 64; ++kk) { const float w = in2_[(size_t)(k0 + kk) * MODC + j];
#pragma unroll
            for (int q = 0; q < 4; ++q) { const f32x4 s = *(const LAS f32x4*)(scr + kk * 16 + 4 * q); acc[4 * q] += s.x * w; acc[4 * q + 1] += s.y * w; acc[4 * q + 2] += s.z * w; acc[4 * q + 3] += s.w * w; } }
#pragma unroll
        for (int b = 0; b < 16; ++b) MODP[((size_t)ks * 16 + b) * MODC + j] = acc[b];
        LDS_WAIT(); asm volatile("" ::: "memory");
    }
    const int gt = (F.vcu * NWAVES + F.wave) * 64 + lane, NGT = NGW * 64;
    float* WF = (float*)(F.ws + WS_WF);
    for (int idx = gt; idx < 8 * 1024; idx += NGT) { const int cidx = idx >> 10, k = idx & 1023; WF[idx] = in5_[(size_t)k * INC + 3072 + cidx]; }
}

__device__ __forceinline__ void p7_wd_items(Frame& F) {
    const int lane = mk_lane();
    const float* const in20_ = inp(F, 20);
    const LAS int* tab = (const LAS int*)(F.lds + TAB_OFF);
    LAS float* scr = (LAS float*)(F.lds + RING_OFF + F.wave * 16384);
    const int total = tab[32] * 2, rounds = (total + F.G - 1) / F.G, rem = total - (rounds - 1) * F.G;
    int rank = F.vcu, n = F.G;
    if (F.G - rem >= 64) { if (F.vcu < rem) return; rank = F.vcu - rem; n = F.G - rem; }
    for (int r = rank * NWAVES + F.wave; r < 32 * 128; r += n * NWAVES) { const int e = r / 128, q = r % 128, kb = q / 32, nb = q % 32;
        tr_item8(in20_ + (size_t)e * 256 * 1024 + (size_t)(64 * kb) * 1024 + 32 * nb, 1024, (unsigned char*)(F.ws + WS_WD) + ((size_t)e * 1024 + COL64ROW(32 * nb)) * 256 + 64 * kb, 256, D8_SCALE, scr, lane); }
}

__device__ __forceinline__ void p1_wquant(Frame& F) {
    const int lane = mk_lane(), tid = F.wave * 64 + lane; (void)tid;
    const float* const in5_ = inp(F, 5);
    LAS float* scr = (LAS float*)(F.lds + RING_OFF + F.wave * 16384);
    const int gw = F.vcu * NWAVES + F.wave, NGW = F.G * NWAVES;
    for (int r = gw; r < 16 * 160; r += NGW) { const int kb = r / 160, nb = r % 160, n0 = 32 * nb, t = n0 >> 8, rho = n0 & 255; int sc;
        const int c64 = 64 * ((rho >> 5) & 3) + 32 * (rho >> 7);
        if (t < 4) sc = rho < 128 ? 128 * t + rho : 1024 + 128 * t + (rho - 128); else if (t < 6) sc = 512 + 256 * (t - 4) + c64;
        else if (t < 10) sc = (t < 8 ? 1536 : 2048) + 256 * (t < 8 ? t - 6 : t - 8) + c64; else if (t < 12) sc = 2560 + 256 * (t - 10) + c64;
        else if (t < 16) sc = 3080 + 256 * (t - 12) + c64; else sc = 4104 + 256 * (t - 16) + c64;
        tr_item_q8(in5_ + (size_t)(64 * kb) * INC + sc, INC, (unsigned char*)(F.ws + WS_WIN8) + (size_t)n0 * 1024 + 64 * kb, 1024, (const unsigned*)(F.ctl + CW_CMAX) + n0, kb == 0 ? (float*)(F.ws + WS_CS) + n0 : nullptr, scr, lane); }
    const float* const in12_ = inp(F, 12);
    for (int r = gw; r < 16 * 32; r += NGW) { const int kb = r / 32, nb = r % 32, n0 = COL64ROW(32 * nb);
        tr_item_q8(in12_ + (size_t)(64 * kb) * 1024 + 32 * nb, 1024, (unsigned char*)(F.ws + WS_WO) + (size_t)n0 * 1024 + 64 * kb, 1024, (const unsigned*)(F.ctl + CW_CMAX) + PP5 + n0, kb == 0 ? (float*)(F.ws + WS_CSO) + n0 : nullptr, scr, lane); }
}
__device__ __forceinline__ void p1_hpass(Frame& F, int panel) {
    const int lane = mk_lane(), tid = F.wave * 64 + lane; (void)tid;
    const float* const in0_ = inp(F, 0);
    const float* const in3_ = inp(F, 3);
    const float* const in4_ = inp(F, 4);
    const float* const in6_ = inp(F, 6);
    const int b = panel / PPS;
    LAS float* smod = (LAS float*)(F.lds + 0);
    constexpr int HPITCH = 2064;
    LAS unsigned char* HROW = F.lds + 8192;
    LAS float* PART = (LAS float*)(F.lds + 8192 + 32 * HPITCH);
    LAS float* LF = (LAS float*)(F.lds + 8192 + 32 * HPITCH + 8192);
    const float* MODP = (const float*)(F.ws + WS_MODP); float* MOD = (float*)(F.ws + WS_MOD);
    const bool writer = (panel % PPS) == 0; const int ncol4 = (writer ? MODC : 2048) / 4;
    for (int j4 = tid; j4 < ncol4; j4 += NWAVES * 64) { f32x4 s = *(const f32x4*)(in3_ + 4 * j4);
#pragma unroll
        for (int ks = 0; ks < 16; ++ks) s += *(const f32x4*)(MODP + ((size_t)ks * 16 + b) * MODC + 4 * j4);
        if (4 * j4 < 2048) *(LAS f32x4*)(smod + 4 * j4) = s;
        if (writer) *(f32x4*)(MOD + (size_t)b * MODC + 4 * j4) = s; }
    pg8::bf16x8 bhi[4], blo[4];
    { const float* WFg = (const float*)(F.ws + WS_WF); const int n = lane & 15, g = lane >> 4;
#pragma unroll
      for (int s = 0; s < 4; ++s) { const int k0 = 128 * F.wave + 32 * s + 8 * g; f32x4 wa = {0.f, 0.f, 0.f, 0.f}, wb = wa;
          if (n < 8) { wa = *(const f32x4*)(WFg + n * 1024 + k0); wb = *(const f32x4*)(WFg + n * 1024 + k0 + 4); }
          const float w8[8] = {wa.x, wa.y, wa.z, wa.w, wb.x, wb.y, wb.z, wb.w}; unsigned hw[8], lw[8];
#pragma unroll
          for (int i = 0; i < 8; ++i) { hw[i] = f2bf(w8[i]); lw[i] = f2bf(w8[i] - __uint_as_float(hw[i] << 16)); }
          bhi[s] = __builtin_bit_cast(pg8::bf16x8, (v4u){hw[0] | (hw[1] << 16), hw[2] | (hw[3] << 16), hw[4] | (hw[5] << 16), hw[6] | (hw[7] << 16)});
          blo[s] = __builtin_bit_cast(pg8::bf16x8, (v4u){lw[0] | (lw[1] << 16), lw[2] | (lw[3] << 16), lw[4] | (lw[5] << 16), lw[6] | (lw[7] << 16)}); } }
    LDS_WAIT(); __syncthreads();
    f32x4 av[4], sh[4];
#pragma unroll
    for (int j = 0; j < 4; ++j) { const int col = 4 * lane + 256 * j; const f32x4 nw = *(const f32x4*)(in4_ + col); const f32x4 sc = *(const LAS f32x4*)(smod + 1024 + col); sh[j] = *(const LAS f32x4*)(smod + col); av[j] = nw * (sc + 1.0f); }
    const float bfg = in6_[lane & 7];
    for (int r0 = 0; r0 < 32; r0 += 4) {
      f32x4 xv[4][4];
#pragma unroll
      for (int q = 0; q < 4; ++q) { const GAS f32x4* xr = (const GAS f32x4*)(in0_ + ((size_t)panel * 256 + F.wave * 32 + r0 + q) * D) + lane;
#pragma unroll
          for (int j = 0; j < 4; ++j) xv[q][j] = xr[64 * j]; }
#pragma unroll
      for (int q = 0; q < 4; ++q) {
        const int rl = F.wave * 32 + r0 + q; const size_t row = (size_t)panel * 256 + rl;
        float ss = 0.f;
#pragma unroll
        for (int j = 0; j < 4; ++j) { const f32x4 t = xv[q][j]; ss += (t.x * t.x + t.y * t.y) + (t.z * t.z + t.w * t.w); }
        const float rstd = 1.0f / sqrtf(wave_sum(ss) * (1.0f / D) + EPS);
        GAS unsigned* o4 = (GAS unsigned*)(F.ws + WS_H8 + row * D) + lane; float am = 0.f;
#pragma unroll
        for (int j = 0; j < 4; ++j) { const f32x4 t = xv[q][j] * rstd * av[j] + sh[j]; xv[q][j] = t; am = fmaxf(fmaxf(am, fmaxf(fabsf(t.x), fabsf(t.y))), fmaxf(fabsf(t.z), fabsf(t.w))); }
        am = wave_max(am); const float inv = am > 0.f ? 127.0f / am : 0.f;
#pragma unroll
        for (int j = 0; j < 4; ++j) { const f32x4 t = xv[q][j] * inv; o4[64 * j] = pk4_i8(t.x, t.y, t.z, t.w); }
        if (lane == 0) ((float*)(F.ws + WS_RS))[row] = am * (1.0f / 127.0f);
#pragma unroll
        for (int j = 0; j < 4; ++j) { const f32x4 t = xv[q][j]; *(LAS v2u*)(HROW + (F.wave * 4 + q) * HPITCH + 512 * j + 8 * lane) = (v2u){pg8::cvt_pk_bf16(t.x, t.y), pg8::cvt_pk_bf16(t.z, t.w)}; }
      }
      LDS_WAIT(); __syncthreads();
      { f32x4 acc0 = {0.f, 0.f, 0.f, 0.f}, acc1 = acc0;
        const LAS unsigned char* ap = HROW + (lane & 15) * HPITCH + (128 * F.wave + 8 * (lane >> 4)) * 2;
#pragma unroll
        for (int s = 0; s < 4; ++s) { const pg8::bf16x8 a0 = *(const LAS pg8::bf16x8*)(ap + 64 * s), a1 = *(const LAS pg8::bf16x8*)(ap + 16 * HPITCH + 64 * s);
            acc0 = __builtin_amdgcn_mfma_f32_16x16x32_bf16(a0, bhi[s], acc0, 0, 0, 0); acc1 = __builtin_amdgcn_mfma_f32_16x16x32_bf16(a1, bhi[s], acc1, 0, 0, 0);
            acc0 = __builtin_amdgcn_mfma_f32_16x16x32_bf16(a0, blo[s], acc0, 0, 0, 0); acc1 = __builtin_amdgcn_mfma_f32_16x16x32_bf16(a1, blo[s], acc1, 0, 0, 0); }
        if ((lane & 15) < 8) {
#pragma unroll
            for (int i = 0; i < 4; ++i) { PART[(F.wave * 32 + 4 * (lane >> 4) + i) * 8 + (lane & 15)] = acc0[i]; PART[(F.wave * 32 + 16 + 4 * (lane >> 4) + i) * 8 + (lane & 15)] = acc1[i]; } } }
      LDS_WAIT(); __syncthreads();
      if (tid < 256) { const int rho = tid >> 3; float z = bfg;
#pragma unroll
          for (int w = 0; w < 8; ++w) z += PART[(w * 32 + rho) * 8 + (tid & 7)];
          const float z2 = z * LOG2E; const int rl = (rho >> 2) * 32 + r0 + (rho & 3);
          LF[rl * 8 + (tid & 7)] = fminf(z2, 0.f) - __builtin_amdgcn_logf(1.0f + __builtin_amdgcn_exp2f(-fabsf(z2))); }
    }
    LDS_WAIT(); __syncthreads();
    {
        const int h = F.wave; const float v0 = LF[(4 * lane) * 8 + h], v1 = LF[(4 * lane + 1) * 8 + h], v2 = LF[(4 * lane + 2) * 8 + h], v3 = LF[(4 * lane + 3) * 8 + h];
        const float s0 = v0, s1 = s0 + v1, s2 = s1 + v2, s3 = s2 + v3; float inc = s3;
#pragma unroll
        for (int o = 1; o < 64; o <<= 1) { const float t = __shfl_up(inc, o); if (lane >= o) inc += t; }
        const float ex = inc - s3;
        float* FL = (float*)(F.ws + WS_FL) + ((size_t)(b * NH + h)) * SEQ + (panel % PPS) * 256 + 4 * lane;
        *(f32x4*)FL = (f32x4){ex + s0, ex + s1, ex + s2, ex + s3};
        if (lane == 63) ((float*)(F.ws + WS_PT))[panel * NH + h] = inc;
    }
    LDS_WAIT(); __syncthreads();
}

__device__ __forceinline__ void p2_router_weights(Frame& F) {
    const int lane = mk_lane();
    const float* const in13_ = inp(F, 13);
    const float* const in14_ = inp(F, 14);
    const float* const in16_ = inp(F, 16);
    const float* MOD = (const float*)(F.ws + WS_MOD);
    bf16* WRB = (bf16*)(F.ws + WS_WRB);
    const int gw = F.vcu * NWAVES + F.wave, NGW = F.G * NWAVES;
    for (int idx = gw * 64 + lane; idx < 16 * 1024; idx += NGW * 64) { const int kk = idx & 1023, b = idx >> 10;
        f32x4 wv[9]; wv[0] = *(const f32x4*)(in14_ + kk * 4);
#pragma unroll
        for (int q = 0; q < 8; ++q) wv[1 + q] = *(const f32x4*)(in16_ + kk * 32 + 4 * q);
        const float a = in13_[kk] * (1.0f + MOD[(size_t)b * MODC + 4 * D + kk]);
        bf16* dst = WRB + (size_t)b * 256 * 1024 + kk;
#pragma unroll
        for (int c = 0; c < 36; ++c) { const float w = wv[c >> 2][c & 3] * a; const unsigned hb = f2bf(w);
            dst[(size_t)c * 1024] = (bf16)hb; dst[(size_t)(40 + c) * 1024] = (bf16)f2bf(w - __uint_as_float(hb << 16)); } }
    if (gw < 16 * 36) { const int b = gw / 36, c = gw % 36; float s = 0.f;
#pragma unroll
        for (int j = 0; j < 16; ++j) { const int kk = lane + 64 * j; s += MOD[(size_t)b * MODC + 3 * D + kk] * (c < 4 ? in14_[kk * 4 + c] : in16_[kk * 32 + (c - 4)]); }
        s = wave_sum(s); if (lane == 0) ((float*)(F.ws + WS_BR))[b * 40 + c] = s; }
}

__device__ __forceinline__ void p4_conv(Frame& F, int panel) {
    const int lane = mk_lane(), tid = F.wave * 64 + lane; (void)tid;
    const float* const in7_ = inp(F, 7);
    bf16* PROJ = (bf16*)(F.ws + WS_PROJ);
    const float* cw = in7_ + 8 * (tid & 63);
    const f32x4 wa0 = *(const f32x4*)cw, wa1 = *(const f32x4*)(cw + 4), wb0 = *(const f32x4*)(cw + CW), wb1 = *(const f32x4*)(cw + CW + 4), wc0 = *(const f32x4*)(cw + 2 * CW), wc1 = *(const f32x4*)(cw + 2 * CW + 4);
    for (int it = tid; it < 256 * 64; it += NWAVES * 64) { const int rl = it >> 6, ch = it & 63; const size_t row = (size_t)panel * 256 + rl; const int t = (int)(row % SEQ);
        const bf16* rp = PROJ + row * PP; const v4u z = {0u, 0u, 0u, 0u};
        const v4u u0 = *(const v4u*)(rp + PC_U + 8 * ch), u1 = t >= 1 ? *(const v4u*)(rp - PP + PC_U + 8 * ch) : z, u2 = t >= 2 ? *(const v4u*)(rp - 2 * PP + PC_U + 8 * ch) : z, bc = *(const v4u*)(rp + PC_B + 8 * ch);
        v4u o;
        o.x = pk2(bflo(bc.x) * (wa0.x * bflo(u2.x) + wb0.x * bflo(u1.x) + wc0.x * bflo(u0.x)), bfhi(bc.x) * (wa0.y * bfhi(u2.x) + wb0.y * bfhi(u1.x) + wc0.y * bfhi(u0.x)));
        o.y = pk2(bflo(bc.y) * (wa0.z * bflo(u2.y) + wb0.z * bflo(u1.y) + wc0.z * bflo(u0.y)), bfhi(bc.y) * (wa0.w * bfhi(u2.y) + wb0.w * bfhi(u1.y) + wc0.w * bfhi(u0.y)));
        o.z = pk2(bflo(bc.z) * (wa1.x * bflo(u2.z) + wb1.x * bflo(u1.z) + wc1.x * bflo(u0.z)), bfhi(bc.z) * (wa1.y * bfhi(u2.z) + wb1.y * bfhi(u1.z) + wc1.y * bfhi(u0.z)));
        o.w = pk2(bflo(bc.w) * (wa1.z * bflo(u2.w) + wb1.z * bflo(u1.w) + wc1.z * bflo(u0.w)), bfhi(bc.w) * (wa1.w * bfhi(u2.w) + wb1.w * bfhi(u1.w) + wc1.w * bfhi(u0.w)));
        *(v4u*)(PROJ + row * PP + PC_C + 8 * ch) = o; }
}

__device__ __forceinline__ void p5_h2pass(Frame& F, int panel) {
    const int lane = mk_lane(), tid = F.wave * 64 + lane; (void)tid;
    const float* const in13_ = inp(F, 13);
    const int b = panel / PPS; const float* MOD = (const float*)(F.ws + WS_MOD) + (size_t)b * MODC;
    f32x4 av[4], sh[4];
#pragma unroll
    for (int j = 0; j < 4; ++j) { const int col = 4 * lane + 256 * j; const f32x4 nw = *(const f32x4*)(in13_ + col); const f32x4 sc = *(const f32x4*)(MOD + 4 * D + col); sh[j] = *(const f32x4*)(MOD + 3 * D + col); av[j] = nw * (sc + 1.0f); }
    for (int r0 = 0; r0 < 32; r0 += 4) {
        const size_t rowb = (size_t)panel * 256 + F.wave * 32 + r0;
        v2u dv[4][4];
#pragma unroll
        for (int q = 0; q < 4; ++q) { const GAS v2u* dr = (const GAS v2u*)((const bf16*)(F.ws + WS_DELTA) + (rowb + q) * D) + lane;
#pragma unroll
            for (int j = 0; j < 4; ++j) dv[q][j] = dr[64 * j]; }
#pragma unroll
        for (int q = 0; q < 4; ++q) { const size_t row = rowb + q;
            f32x4 v[4]; float ss = 0.f;
#pragma unroll
            for (int j = 0; j < 4; ++j) { const v2u dd = dv[q][j]; v[j] = (f32x4){bflo(dd.x), bfhi(dd.x), bflo(dd.y), bfhi(dd.y)}; ss += (v[j].x * v[j].x + v[j].y * v[j].y) + (v[j].z * v[j].z + v[j].w * v[j].w); }
            const float rstd = 1.0f / sqrtf(wave_sum(ss) * (1.0f / D) + EPS);
            if (lane == 0) ((LAS float*)(F.lds + pg8::NA_LDS_OFF))[F.wave * 32 + r0 + q] = rstd;
#pragma unroll
            for (int j = 0; j < 4; ++j) v[j] = v[j] * rstd * av[j] + sh[j];
            GAS unsigned* o4 = (GAS unsigned*)(F.ws + WS_H8 + row * D) + lane;
#pragma unroll
            for (int j = 0; j < 4; ++j) o4[64 * j] = pk4_fp8(v[j].x, v[j].y, v[j].z, v[j].w); }
    }
}
__device__ __forceinline__ void p5_route(Frame& F, int panel) {
    const int lane = mk_lane(), tid = F.wave * 64 + lane; (void)tid;
    const float* const in15_ = inp(F, 15);
    const float* const in17_ = inp(F, 17);
    LAS int* lcnt = (LAS int*)(F.lds + TAB_OFF + 512); LAS int* gbase = (LAS int*)(F.lds + TAB_OFF + 768);
    if (tid < 32) lcnt[tid] = 0;
    LDS_WAIT(); __syncthreads();
    int e1 = 0, e2 = 0, r1 = 0, r2 = 0; float w1 = 0.f, w2 = 0.f; const int row = panel * 256 + tid;
    if (tid < 256) {
        const float* lg = (const float*)(F.ws + WS_LOG) + (size_t)row * NLOG;
        float g[4];
        const float* br = (const float*)(F.ws + WS_BR) + (panel / PPS) * 40;
#pragma unroll
        for (int k = 0; k < 4; ++k) g[k] = lg[k] + lg[40 + k] + in15_[k] + br[k];
        int gi = 0; float best = g[0];
#pragma unroll
        for (int k = 1; k < 4; ++k) if (g[k] > best) { best = g[k]; gi = k; }
        float den = 0.f;
#pragma unroll
        for (int k = 0; k < 4; ++k) den += expf(g[k] - best);
        const float psel = 1.0f / den;
        float le[8];
#pragma unroll
        for (int j = 0; j < 8; ++j) le[j] = lg[4 + 8 * gi + j] + lg[44 + 8 * gi + j] + in17_[8 * gi + j] + br[4 + 8 * gi + j];
        int i1 = 0; float v1 = le[0];
#pragma unroll
        for (int j = 1; j < 8; ++j) if (le[j] > v1) { v1 = le[j]; i1 = j; }
        int i2 = -1; float v2 = -INFINITY;
#pragma unroll
        for (int j = 0; j < 8; ++j) if (j != i1 && (i2 < 0 || le[j] > v2)) { v2 = le[j]; i2 = j; }
        const float s = expf(v2 - v1); w1 = psel / (1.0f + s); w2 = psel * s / (1.0f + s);
        e1 = 8 * gi + i1; e2 = 8 * gi + i2;
        r1 = __hip_atomic_fetch_add(lcnt + e1, 1, __ATOMIC_RELAXED, __HIP_MEMORY_SCOPE_WORKGROUP);
        r2 = __hip_atomic_fetch_add(lcnt + e2, 1, __ATOMIC_RELAXED, __HIP_MEMORY_SCOPE_WORKGROUP);
    }
    LDS_WAIT(); __syncthreads();
    if (tid < 32) { const int n = lcnt[tid]; gbase[tid] = n > 0 ? (int)__hip_atomic_fetch_add((unsigned*)(F.ctl + CW_CNT + tid), (unsigned)n, RLX_AGENT) : 0; }
    LDS_WAIT(); __syncthreads();
    if (tid < 256) {
        const int p1 = gbase[e1] + r1, p2 = gbase[e2] + r2;
        int* LIST = (int*)(F.ws + WS_LIST); float* WL = (float*)(F.ws + WS_WLIST);
        LIST[(size_t)e1 * LISTCAP + p1] = row; WL[(size_t)e1 * LISTCAP + p1] = w1;
        LIST[(size_t)e2 * LISTCAP + p2] = row; WL[(size_t)e2 * LISTCAP + p2] = w2;
        ((int*)(F.ws + WS_POS))[2 * row] = (e1 << 17) | p1; ((int*)(F.ws + WS_POS))[2 * row + 1] = (e2 << 17) | p2;
    }
}
__device__ __forceinline__ void moe_tables(Frame& F) {
    const int lane = mk_lane(), tid = F.wave * 64 + lane; (void)tid;
    LAS int* tab = (LAS int*)(F.lds + TAB_OFF);
    if (tid == 0) { int acc = 0;
#pragma unroll
        for (int e = 0; e < NE; ++e) { int n = (int)__hip_atomic_load((unsigned*)(F.ctl + CW_CNT + e), RLX_AGENT); if (n > LISTCAP) n = LISTCAP; tab[e] = acc; tab[64 + e] = n; acc += (n + 255) >> 8; }
        tab[32] = acc; }
    LDS_WAIT(); __syncthreads();
    const int ttot = tab[32];
    for (int T = tid; T < ttot && T < 1024; T += NWAVES * 64) { int e = 0;
#pragma unroll 4
        for (int j = 1; j < NE; ++j) e += (T >= tab[j]) ? 1 : 0;
        tab[256 + T] = e; }
    LDS_WAIT(); __syncthreads();
}
__device__ __forceinline__ void p8_combine(Frame& F) {
    const int lane = mk_lane(), tid = F.wave * 64 + lane; (void)tid;
    const LAS int* tab = (const LAS int*)(F.lds + TAB_OFF);
    const unsigned char* Y = (const unsigned char*)(F.ws + WS_Y); const int* POS = (const int*)(F.ws + WS_POS); const float* MOD = (const float*)(F.ws + WS_MOD);
    typedef float f32x2c __attribute__((ext_vector_type(2)));
    const int gw = F.vcu * NWAVES + F.wave, NGW = F.G * NWAVES, RPW = M / NGW;
    const int row0 = gw * RPW, b = row0 / SEQ;
    f32x4 g2[4];
#pragma unroll
    for (int q = 0; q < 4; ++q) g2[q] = *(const f32x4*)(MOD + (size_t)b * MODC + 5 * D + 4 * lane + 256 * q) * (1.0f / Y8_SCALE);
    for (int r0 = 0; r0 < RPW; r0 += 2) {
        unsigned y1[2][4], y2[2][4]; v2u xs[2][4];
#pragma unroll
        for (int u = 0; u < 2; ++u) { const int row = row0 + r0 + u; const int k1 = POS[2 * row], k2 = POS[2 * row + 1];
            const size_t q1 = (size_t)tab[k1 >> 17] * 256 + (k1 & 0x1ffff), q2 = (size_t)tab[k2 >> 17] * 256 + (k2 & 0x1ffff);
            const GAS unsigned* p1 = (const GAS unsigned*)(Y + q1 * 1024) + lane; const GAS unsigned* p2 = (const GAS unsigned*)(Y + q2 * 1024) + lane;
            const GAS v2u* px = (const GAS v2u*)((const bf16*)(F.ws + WS_DELTA) + (size_t)row * D) + lane;
#pragma unroll
            for (int q = 0; q < 4; ++q) { y1[u][q] = p1[64 * q]; y2[u][q] = p2[64 * q]; xs[u][q] = px[64 * q]; } }
#pragma unroll
        for (int u = 0; u < 2; ++u) { GAS f32x4* po = (GAS f32x4*)(F.out + (size_t)(row0 + r0 + u) * D) + lane;
#pragma unroll
            for (int q = 0; q < 4; ++q) { const unsigned a = y1[u][q], c = y2[u][q];
                const f32x2c a0 = __builtin_amdgcn_cvt_pk_f32_fp8((int)a, false), a1 = __builtin_amdgcn_cvt_pk_f32_fp8((int)a, true), c0 = __builtin_amdgcn_cvt_pk_f32_fp8((int)c, false), c1 = __builtin_amdgcn_cvt_pk_f32_fp8((int)c, true);
                const v2u dd = xs[u][q]; const f32x4 g = g2[q]; f32x4 x = (f32x4){bflo(dd.x), bfhi(dd.x), bflo(dd.y), bfhi(dd.y)};
                x.x += g.x * (a0.x + c0.x); x.y += g.y * (a0.y + c0.y); x.z += g.z * (a1.x + c1.x); x.w += g.w * (a1.y + c1.y);
                po[64 * q] = x; } }
    }
}

struct Args { const float* in[21]; float* out; unsigned char* ws; int ph_lo, ph_hi, li, pad; };
__global__ void __launch_bounds__(NWAVES * 64, 2) mk_fwd(Args args) {
    extern __shared__ __attribute__((aligned(16))) unsigned char lds[];
    Frame F;
    F.lds = (LAS unsigned char*)lds;
    F.MISC = (volatile LAS unsigned*)(F.lds + MISC_OFF);
    F.wave = __builtin_amdgcn_readfirstlane((int)threadIdx.x >> 6);
    F.G = gridDim.x; { const int bx = blockIdx.x; F.vcu = (F.G % 8 == 0) ? (bx % 8) * (F.G / 8) + bx / 8 : bx; }
    unsigned char* ws = args.ws; F.ws = ws; F.out = args.out;
    F.ctl = (gu32*)(ws + WS_CTL);
    for (int u = threadIdx.x; u < (LDS_BYTES - LDSCTL_OFF) / 4; u += NWAVES * 64) ((LAS unsigned*)(F.lds + LDSCTL_OFF))[u] = 0u;
    __syncthreads();
    F.ptab = (const LAS unsigned long long*)(F.lds + PTR_OFF);
    if (threadIdx.x == 0) { LAS unsigned long long* pt = (LAS unsigned long long*)(F.lds + PTR_OFF);
        pt[0] = (unsigned long long)args.in[0];
        pt[1] = (unsigned long long)args.in[1];
        pt[2] = (unsigned long long)args.in[2];
        pt[3] = (unsigned long long)args.in[3];
        pt[4] = (unsigned long long)args.in[4];
        pt[5] = (unsigned long long)args.in[5];
        pt[6] = (unsigned long long)args.in[6];
        pt[7] = (unsigned long long)args.in[7];
        pt[8] = (unsigned long long)args.in[8];
        pt[9] = (unsigned long long)args.in[9];
        pt[10] = (unsigned long long)args.in[10];
        pt[11] = (unsigned long long)args.in[11];
        pt[12] = (unsigned long long)args.in[12];
        pt[13] = (unsigned long long)args.in[13];
        pt[14] = (unsigned long long)args.in[14];
        pt[15] = (unsigned long long)args.in[15];
        pt[16] = (unsigned long long)args.in[16];
        pt[17] = (unsigned long long)args.in[17];
        pt[18] = (unsigned long long)args.in[18];
        pt[19] = (unsigned long long)args.in[19];
        pt[20] = (unsigned long long)args.in[20];
    }
    __syncthreads();
    XcdBarrier bar; bar.bar = (unsigned*)(F.ctl + CW_BAR); bar.x = 0; bar.st = nullptr;
    if (N_LAUNCHES == 1) bar = xcd_barrier_post((unsigned*)(F.ctl + CW_BAR), F.MISC + 8, threadIdx.x == 0);
#define GRID_BAR() do { if (N_LAUNCHES == 1) xcd_barrier(bar, F.wave == 0 && mk_lane() == 0); } while (0)
#define WG_SYNC() do { VM_WAIT(); __syncthreads(); } while (0)
    const int lo = args.ph_lo, hi = args.ph_hi;
#ifndef REP_P9
#define REP_P9 1
#endif
#ifndef REP_H2
#define REP_H2 1
#endif
#ifndef REP_WQ
#define REP_WQ 1
#endif
#ifndef REP_P0
#define REP_P0 1
#endif
#ifndef REP_P1
#define REP_P1 1
#endif
#ifndef REP_P2
#define REP_P2 1
#endif
#ifndef REP_CONV
#define REP_CONV 1
#endif
#ifndef REP_G12
#define REP_G12 1
#endif
#ifndef REP_G3
#define REP_G3 1
#endif
#ifndef REP_P6
#define REP_P6 1
#endif
#ifndef REP_P7
#define REP_P7 1
#endif
#ifndef P2_MASK
#define P2_MASK 3
#endif
#ifndef P5_MASK
#define P5_MASK 0x3f
#endif
#ifndef PHASE_MASK
#define PHASE_MASK 0x3ff
#endif
#define IN(k) ((((PHASE_MASK) >> (k)) & 1) && lo <= (k) && (k) < hi)
#define BOTH(k) (IN(k) && IN((k) + 1))
    const int panel = F.vcu;
    bf16* const H = (bf16*)(ws + WS_H); bf16* const PROJ = (bf16*)(ws + WS_PROJ);

    if (IN(0)) { _Pragma("nounroll") for (int rep = 0; rep < REP_P0; ++rep) p0_prologue(F); if (BOTH(0)) GRID_BAR(); }
    if (IN(1)) { _Pragma("nounroll") for (int rep = 0; rep < REP_WQ; ++rep) p1_wquant(F); LDS_WAIT(); __syncthreads(); _Pragma("nounroll") for (int rep = 0; rep < REP_P1; ++rep) if (panel < NPANEL) p1_hpass(F, panel); if (BOTH(1)) GRID_BAR(); }
#ifndef STAG2
#define STAG2 0
#endif
#ifndef STAG5
#define STAG5 0
#endif
#define XCD_STAGGER(n) do { if (blockIdx.x & 1) { _Pragma("unroll") for (int s_ = 0; s_ < (n); ++s_) __builtin_amdgcn_s_sleep(127); } } while (0)
    if (IN(2)) {
        XCD_STAGGER(STAG2);
        p2_router_weights(F);
        {
            pg8::DenseStatic S; S.A = (const char*)(ws + WS_H8); S.Bt = (const char*)(ws + WS_WIN8); S.a_tstep = (size_t)256 * D; S.b_tstep = (size_t)256 * D; S.so.init(M, PP5, F.G, (int)blockIdx.x);
            pg8::EpiInProj E{PROJ, (bf16*)(ws + WS_KB), (bf16*)(ws + WS_VB), inp(F, 8), inp(F, 9), (const float*)(ws + WS_RS), (const float*)(ws + WS_CS), F.lds + OST_OFF, F.lds + pg8::NA_LDS_OFF};
            _Pragma("nounroll") for (int rep = 0; rep < REP_P2; ++rep) pg8::gemm_phase<pg8::EpiInProj, pg8::DenseStatic, false, true, false, true>(F.lds + RING_OFF, F.wave, D, D, S, E); }
        if (BOTH(2)) GRID_BAR();
    }
    if (IN(3)) {
        const bool conv_first = true;
        if (conv_first && panel < NPANEL) p4_conv(F, panel);
        static_assert(attn_body::ATTN_LDS_BYTES <= RING_BYTES && attn_body::ATTN_PITCH == PP, "attention body geometry vs frame");
        float prune, zref; int nomax;
        { const int l_ = mk_lane(); const float bq = wave_max(fabsf(inp(F, 8)[l_])), bk = wave_max(fabsf(inp(F, 9)[l_])); prune = __builtin_bit_cast(float, __builtin_amdgcn_readfirstlane(__builtin_bit_cast(int, -(37.5f + 2.0f * 11.6f * bq * bk))));
          nomax = __builtin_amdgcn_readfirstlane(11.6f * bq * bk < 60.0f ? 1 : 0);
          zref = __builtin_bit_cast(float, __builtin_amdgcn_readfirstlane(__builtin_bit_cast(int, -(90.0f - 11.6f * bq * bk)))); }
        const attn_body::AttnTensors AT{(const attn_body::bf16*)(PROJ + PC_Q), (const attn_body::bf16*)(ws + WS_KB), (const attn_body::bf16*)(ws + WS_VB), (attn_body::bf16*)(PROJ + PC_Q),
                                        (const float*)(ws + WS_FL), (const float*)(ws + WS_PT), prune, nomax, zref};
        const attn_body::DynOrder S{(unsigned*)(F.ctl + CW_ATTQ), F.MISC + 16, F.wave};
        attn_body::attn_phase<attn_body::DynOrder>((char*)lds + RING_OFF, AT, S, F.wave);
        if (!conv_first && panel < NPANEL) p4_conv(F, panel);
        if (BOTH(3)) GRID_BAR();
    }
    if (IN(4)) {
        pg8::DenseStatic S; S.A = (const char*)(PROJ + PC_C); S.Bt = (const char*)(ws + WS_WOC); S.a_tstep = (size_t)256 * PP * 2; S.b_tstep = (size_t)256 * D * 2; S.so.init(M, D, F.G, (int)blockIdx.x);
#if defined(PROBE_P4_NULL)
        { pg8::EpiNull EN; pg8::gemm_phase<pg8::EpiNull, pg8::DenseStatic, false, true>(F.lds + RING_OFF, F.wave, PP, D, S, EN); }
#endif
        pg8::EpiMerge E{PROJ, (unsigned char*)H, (signed char*)(ws + WS_EX), F.lds + OST_OFF, F.lds + pg8::NA_LDS_OFF};
        _Pragma("nounroll") for (int rep = 0; rep < REP_G12; ++rep) pg8::gemm_phase<pg8::EpiMerge, pg8::DenseStatic, false, true>(F.lds + RING_OFF, F.wave, PP, D, S, E);
        if (BOTH(4)) GRID_BAR();
    }
    if (IN(5)) {
        XCD_STAGGER(STAG5);
        pg8::DenseStatic S; S.A = (const char*)H; S.Bt = (const char*)(ws + WS_WO); S.a_tstep = (size_t)256 * D; S.b_tstep = (size_t)256 * D; S.so.init(M, D, F.G, (int)blockIdx.x);
        pg8::EpiDelta8 E{(const float*)(ws + WS_MOD), inp(F, 0), (bf16*)(ws + WS_DELTA), (const signed char*)(ws + WS_EX), (const float*)(ws + WS_CSO), F.lds + OST_OFF};
        _Pragma("nounroll") for (int rep = 0; rep < REP_G3; ++rep) pg8::gemm_phase<pg8::EpiDelta8, pg8::DenseStatic, false, true, false, true>(F.lds + RING_OFF, F.wave, D, D, S, E);
        if (BOTH(5)) GRID_BAR();
    }
    if (IN(6)) {
        if (panel < NPANEL) {
            _Pragma("nounroll") for (int rep = 0; rep < REP_H2; ++rep) p5_h2pass(F, panel);
            WG_SYNC();
            { pg8::OwnPanel S{(const char*)(ws + WS_DELTA), (const char*)(ws + WS_WRB + (size_t)(panel / PPS) * 256 * D * 2), (size_t)256 * D * 2, (size_t)256 * D * 2, panel, 1};
              pg8::EpiLogits E{(float*)(ws + WS_LOG), NLOG, NLOG, (const LAS float*)(F.lds + pg8::NA_LDS_OFF)};
              pg8::gemm_phase<pg8::EpiLogits, pg8::OwnPanel, false, false, false, false, true>(F.lds + RING_OFF, F.wave, D, D, S, E); }
            WG_SYNC();
            p5_route(F, panel);
        }
        if (BOTH(6)) GRID_BAR();
    }
    if (IN(7)) {
        moe_tables(F);
        typedef pg8::MoeSched<2, 0, (size_t)512 * D, (size_t)256 * D> Sched7;
        Sched7 S{(const char*)(ws + WS_H8), (const char*)(ws + WS_WGU), (const int*)(ws + WS_LIST), (const LAS int*)(F.lds + TAB_OFF), F.G, F.vcu};
        pg8::EpiGLU E{(unsigned char*)(ws + WS_ACT), (const float*)(ws + WS_WLIST), 1.0f / W8_SCALE, F.lds + OST_OFF};
        _Pragma("nounroll") for (int rep = 0; rep < REP_P6; ++rep) pg8::gemm_phase<pg8::EpiGLU, Sched7, true, true, true>(F.lds + RING_OFF, F.wave, D, D, S, E);
        p7_wd_items(F);
        if (BOTH(7)) GRID_BAR();
    }
    if (IN(8)) {
        if (!(IN(7))) moe_tables(F);
        typedef pg8::MoeSched<4, (size_t)256 * DE, (size_t)D * DE, (size_t)256 * DE> Sched8;
        Sched8 S{(const char*)(ws + WS_ACT), (const char*)(ws + WS_WD), (const int*)(ws + WS_LIST), (const LAS int*)(F.lds + TAB_OFF), F.G, F.vcu};
        pg8::EpiFp8Plain E{(unsigned char*)(ws + WS_Y), D, Y8_SCALE / (A8_SCALE * D8_SCALE), F.lds + OST_OFF};
        _Pragma("nounroll") for (int rep = 0; rep < REP_P7; ++rep) pg8::gemm_phase<pg8::EpiFp8Plain, Sched8, false, true, true>(F.lds + RING_OFF, F.wave, DE, DE, S, E);
        if (BOTH(8)) GRID_BAR();
    }
    if (IN(9)) { if (!(IN(7)) && !(IN(8))) moe_tables(F); _Pragma("nounroll") for (int rep = 0; rep < REP_P9; ++rep) p8_combine(F); }
#undef IN
#undef BOTH
}

extern "C" void kernel_launch(void* const* d_in, const int* in_sizes, int n_in, void* d_out, int out_size, void* d_ws, size_t ws_size, hipStream_t stream) {
    static int grid = 0;
    if (grid == 0) {
        if (n_in != 21 || in_sizes[0] != M * D || out_size != M * D || ws_size < WS_END) { fprintf(stderr, "kernel_launch: unexpected shapes (n_in %d, in0 %d, out %d, ws %zu); nothing launched\n", n_in, n_in > 0 ? in_sizes[0] : -1, out_size, ws_size); grid = -1; return; }
        if (hipFuncSetAttribute((const void*)mk_fwd, hipFuncAttributeMaxDynamicSharedMemorySize, LDS_BYTES) != hipSuccess) { fprintf(stderr, "kernel_launch: hipFuncSetAttribute failed\n"); grid = -1; return; }
        int per_cu = 0;
        if (hipOccupancyMaxActiveBlocksPerMultiprocessor(&per_cu, (const void*)mk_fwd, NWAVES * 64, LDS_BYTES) != hipSuccess || per_cu < 1) fprintf(stderr, "kernel_launch: note: occupancy query reports %d\n", per_cu);
        (void)hipGetLastError();
        grid = 256;
    }
    if (grid < 0) return;
    if (hipMemsetAsync((char*)d_ws + WS_CTL, 0, CTL_ZERO_BYTES, stream) != hipSuccess) { fprintf(stderr, "kernel_launch: hipMemsetAsync failed\n"); return; }
    Args a{};
    for (int i = 0; i < 21; ++i) a.in[i] = (const float*)d_in[i];
    a.out = (float*)d_out; a.ws = (unsigned char*)d_ws;
    for (int li = 0; li < N_LAUNCHES; ++li) {
        if (N_LAUNCHES == 1) { a.ph_lo = 0; a.ph_hi = N_PHASES; } else { a.ph_lo = li; a.ph_hi = li + 1; }
        a.li = li;
        hipLaunchKernelGGL(mk_fwd, dim3(grid), dim3(NWAVES * 64), LDS_BYTES, stream, a);
        const hipError_t le = hipPeekAtLastError();
        if (le != hipSuccess) { fprintf(stderr, "kernel_launch: launch %d failed: %s\n", li, hipGetErrorName(le)); break; }
    }
}
```

```cpp
#include <hip/hip_runtime.h>
#include <cstdio>
#include <cstdint>
__device__ __forceinline__ int mk_lane() { int l; asm volatile("v_mbcnt_lo_u32_b32 %0, -1, 0\n\tv_mbcnt_hi_u32_b32 %0, -1, %0" : "=v"(l)); return l; }
#define MK_N_LAUNCHES 1
namespace pg8 {
#define PG8_LAS __attribute__((address_space(3)))
typedef unsigned short bf16_t;
typedef short bf16x8 __attribute__((ext_vector_type(8)));
typedef float f32x4 __attribute__((ext_vector_type(4)));
typedef unsigned u32x4 __attribute__((ext_vector_type(4)));
typedef int v4i_t __attribute__((ext_vector_type(4)));
typedef int v8i_t __attribute__((ext_vector_type(8)));
constexpr int BM = 256, BK = 64, HALF = 128, HTB = HALF * BK * 2  , STAGE_BYTES = 8 * HTB, NXCD = 8, WGM = 8;
constexpr int RAW_LDS_OFF = 161792;
constexpr int NA_LDS_OFF = 137216;

__host__ __device__ __forceinline__ int lds_byte(int r, int c) { const int st = (r >> 4) * 2 + (c >> 5), rr = r & 15, cc = c & 31, ob = rr * 64 + cc * 2; return st * 1024 + (ob ^ (((ob >> 9) & 1) << 5)); }
__host__ __device__ __forceinline__ void stage_rc(int b, int& R, int& C) { const int st = b / 1024, sb = b % 1024, swz = sb ^ (((sb >> 9) & 1) << 5); R = (st >> 1) * 16 + swz / 64; C = (st & 1) * 32 + (swz % 64) / 2; }
__host__ __device__ __forceinline__ int perm32(int rho) { const int n = rho >> 4, i = rho & 15; return 8 * (i >> 2) + 4 * n + (i & 3); }

struct Unit { int pm, pn, e, lt, cnt; };

struct StaticOrderCore {
    int nM, nN, nwg, G, c;
    __device__ __forceinline__ void init(int M, int N, int G_, int c_) { nM = M / BM; nN = N / BM; nwg = nM * nN; G = G_; c = c_; }
    __device__ __forceinline__ bool next(int i, Unit& u) const {
        const long L = (long)i * G + c; if (L >= nwg) return false;
        int wgid = (int)L; { const int q = nwg / NXCD, r = nwg % NXCD, xcd = wgid % NXCD, off = wgid / NXCD; wgid = (xcd < r ? xcd * (q + 1) : r * (q + 1) + (xcd - r) * q) + off; }
        const int nig = WGM * nN, gid = wgid / nig, fm = gid * WGM, gsz = (nM - fm) < WGM ? (nM - fm) : WGM;
        u.pm = __builtin_amdgcn_readfirstlane(fm + ((wgid % nig) % gsz)); u.pn = __builtin_amdgcn_readfirstlane((wgid % nig) / gsz); u.e = 0; u.lt = 0; u.cnt = 0; return true;
    }
};
struct DenseStatic {
    const char* A; const char* Bt; size_t a_tstep, b_tstep; StaticOrderCore so;
    __device__ __forceinline__ bool next(int i, Unit& u) const { return so.next(i, u); }
    __device__ __forceinline__ const char* a_base(const Unit& u) const { return A + (size_t)u.pm * a_tstep; }
    __device__ __forceinline__ const char* b_base(const Unit& u) const { return Bt + (size_t)u.pn * b_tstep; }
    __device__ __forceinline__ int row_index(const Unit&, int) const { return 0; }
};
struct OwnPanel {
    const char* A; const char* Bt; size_t a_tstep, b_tstep; int panel, nN;
    __device__ __forceinline__ bool next(int i, Unit& u) const { if (i >= nN) return false; u.pm = __builtin_amdgcn_readfirstlane(panel); u.pn = i; u.e = 0; u.lt = 0; u.cnt = 0; return true; }
    __device__ __forceinline__ const char* a_base(const Unit& u) const { return A + (size_t)u.pm * a_tstep; }
    __device__ __forceinline__ const char* b_base(const Unit& u) const { return Bt + (size_t)u.pn * b_tstep; }
    __device__ __forceinline__ int row_index(const Unit&, int) const { return 0; }
};

__device__ __forceinline__ unsigned cvt_pk_bf16(float lo, float hi) { unsigned r; asm volatile("v_cvt_pk_bf16_f32 %0, %1, %2" : "=v"(r) : "v"(lo), "v"(hi)); return r; }
__device__ __forceinline__ float bf_lo(unsigned w) { return __uint_as_float(w << 16); }
__device__ __forceinline__ float bf_hi(unsigned w) { return __uint_as_float(w & 0xffff0000u); }
__device__ __forceinline__ float sigmoid_f(float x) { return __builtin_amdgcn_rcpf(1.0f + __builtin_amdgcn_exp2f(-1.4426950408889634f * x)); }

__device__ __forceinline__ void glds16_s(const void* sbase, unsigned voff, unsigned lds_dst) {
    unsigned keep;
    asm volatile("s_mov_b32 %0, m0\n\ts_mov_b32 m0, %3\n\ts_nop 0\n\tglobal_load_lds_dwordx4 %1, %2\n\ts_mov_b32 m0, %0" : "=&s"(keep) : "v"(voff), "s"(sbase), "s"(lds_dst) : "memory");
}
__device__ __forceinline__ void glds4_s(const void* sbase, unsigned voff, unsigned lds_dst) {
    unsigned keep;
    asm volatile("s_mov_b32 %0, m0\n\ts_mov_b32 m0, %3\n\ts_nop 0\n\tglobal_load_lds_dword %1, %2\n\ts_mov_b32 m0, %0" : "=&s"(keep) : "v"(voff), "s"(sbase), "s"(lds_dst) : "memory");
}
struct OwnPanelRot {
    const char* A; const char* Bt; size_t a_tstep, b_tstep; int panel, nN;
    __device__ __forceinline__ bool next(int i, Unit& u) const { if (i >= nN) return false; u.pm = __builtin_amdgcn_readfirstlane(panel); u.pn = __builtin_amdgcn_readfirstlane((i + panel) & (nN - 1)); u.e = 0; u.lt = 0; u.cnt = 0; return true; }
    __device__ __forceinline__ const char* a_base(const Unit& u) const { return A + (size_t)u.pm * a_tstep; }
    __device__ __forceinline__ const char* b_base(const Unit& u) const { return Bt + (size_t)u.pn * b_tstep; }
    __device__ __forceinline__ int row_index(const Unit&, int) const { return 0; }
};
template <class Epi, class Sched, bool GATHER, bool ALIGN_EPI, bool FP8 = false, bool I8 = false, bool HALFN = false>
__device__ __forceinline__ void gemm_phase(PG8_LAS unsigned char* lds, const int wave, const int lda_e, const int K_e, const Sched& S, const Epi& E) {
    const int lda = (FP8 || I8) ? lda_e / 2 : lda_e, K = (FP8 || I8) ? K_e / 2 : K_e;
    const int lane = mk_lane(), wid = wave, tid = wid * 64 + lane, wr = wid >> 2, wc = wid & 3, fr = lane & 15, fq = lane >> 4;
    const int nt = K / BK;
    static_assert(!(HALFN && Epi::NVM > 0), "HALFN counts its own waits");
    int Rr[2], Cc[2];
    unsigned voffB[2], va0[2], va1[2];
#pragma unroll
    for (int i = 0; i < 2; ++i) { stage_rc(tid * 16 + i * 8192, Rr[i], Cc[i]); const int Rb = Epi::PERM ? ((Rr[i] & ~31) + perm32(Rr[i] & 31)) : Rr[i];
        voffB[i] = (unsigned)(Rb * K + Cc[i]) * 2u; va0[i] = (unsigned)(Rr[i] * lda + Cc[i]) * 2u; va1[i] = va0[i] + (unsigned)(HALF * lda) * 2u; }
    const size_t kstep = (size_t)(BK * 2);
    const size_t hstepB = (size_t)HALF * K * 2;
    const unsigned ldsb = (unsigned)(__SIZE_TYPE__)lds + (unsigned)wid * 1024u;
    const int aoff = lds_byte(wr * 64 + fr, fq * 8), boff = lds_byte(wc * 32 + fr, fq * 8);
#define PG8_SA(b, h) (((b) * 2 + (h)) * HTB)
#define PG8_SB(b, h) ((4 + (b) * 2 + (h)) * HTB)
#define PG8_STAGE2(bufoff, gbase, o0, o1) do { glds16_s((gbase), (o0), ldsb + (unsigned)(bufoff)); glds16_s((gbase), (o1), ldsb + (unsigned)(bufoff) + 8192u); } while (0)
#define PG8_LD8(p) __builtin_shufflevector(*(const PG8_LAS v4i_t*)(p), *(const PG8_LAS v4i_t*)((p) + 1024), 0, 1, 2, 3, 4, 5, 6, 7)
#define PG8_LDA(dst, b, h) do { _Pragma("unroll") for (int m = 0; m < 4; ++m) { if constexpr (FP8) dst##8[m] = PG8_LD8(lds + PG8_SA(b, h) + aoff + m * 2048); else { _Pragma("unroll") for (int k = 0; k < 2; ++k) dst[m][k] = *(const PG8_LAS bf16x8*)(lds + PG8_SA(b, h) + aoff + m * 2048 + k * 1024); } } } while (0)
#define PG8_LDB(dst, b, h) do { _Pragma("unroll") for (int n = 0; n < 2; ++n) { if constexpr (FP8) dst##8[n] = PG8_LD8(lds + PG8_SB(b, h) + boff + n * 2048); else { _Pragma("unroll") for (int k = 0; k < 2; ++k) dst[n][k] = *(const PG8_LAS bf16x8*)(lds + PG8_SB(b, h) + boff + n * 2048 + k * 1024); } } } while (0)
#define PG8_MMA(ai, bj, At, Bt) do { __builtin_amdgcn_s_setprio(1); _Pragma("unroll") for (int m = 0; m < 4; ++m) _Pragma("unroll") for (int n = 0; n < 2; ++n) { \
        if constexpr (FP8) acc[ai][bj][m][n] = __builtin_amdgcn_mfma_scale_f32_16x16x128_f8f6f4(Bt##8[n], At##8[m], acc[ai][bj][m][n], 0, 0, 0, 0x7f7f7f7f, 0, 0x7f7f7f7f); \
        else if constexpr (I8) { _Pragma("unroll") for (int k = 0; k < 2; ++k) acc[ai][bj][m][n] = __builtin_bit_cast(f32x4, __builtin_amdgcn_mfma_i32_16x16x64_i8(__builtin_bit_cast(v4i_t, Bt[n][k]), __builtin_bit_cast(v4i_t, At[m][k]), __builtin_bit_cast(v4i_t, acc[ai][bj][m][n]), 0, 0, 0)); } \
        else { _Pragma("unroll") for (int k = 0; k < 2; ++k) acc[ai][bj][m][n] = __builtin_amdgcn_mfma_f32_16x16x32_bf16(Bt[n][k], At[m][k], acc[ai][bj][m][n], 0, 0, 0); } } __builtin_amdgcn_s_setprio(0); } while (0)
#define PG8_WAIT_V(n) asm volatile("s_waitcnt vmcnt(" #n ")" ::: "memory")
#define PG8_WAIT_K() do { if constexpr (HALFN) PG8_WAIT_V(6); else PG8_WAIT_V(8); } while (0)
#define PG8_STAGE_B1(bufoff, gbase) do { if constexpr (!HALFN) PG8_STAGE2(bufoff, gbase, voffB[0], voffB[1]); } while (0)
#define PG8_WAIT_L(n) asm volatile("s_waitcnt lgkmcnt(" #n ")" ::: "memory")
#define PG8_WAIT_VX(p) do { if (p) asm volatile("s_waitcnt vmcnt(%0)" :: "n"(8 + (Epi::NVM > 0 ? Epi::NVM : 0)) : "memory"); else PG8_WAIT_K(); } while (0)
#define PG8_BAR __builtin_amdgcn_s_barrier()
#define PG8_SCHED __builtin_amdgcn_sched_barrier(0)
    Unit cur, nxt; int ui = 0;
    if (!S.next(0, cur)) return;
#define PG8_VMFLUSH(n) __builtin_amdgcn_s_waitcnt(0x0F70 | ((n) & 15) | (((n) >> 4) << 14))
    PG8_VMFLUSH(0);
    f32x4 acc[2][2][4][2];
#pragma unroll
    for (int a = 0; a < 2; ++a)
#pragma unroll
        for (int b = 0; b < 2; ++b)
#pragma unroll
            for (int m = 0; m < 4; ++m)
#pragma unroll
                for (int n = 0; n < 2; ++n) acc[a][b][m][n] = (f32x4){0.f, 0.f, 0.f, 0.f};
    bf16x8 At[4][2], B0[2][2], B1[2][2]; v8i_t At8[4], B08[2], B18[2];
    const char* cA = S.a_base(cur); const char* cB = S.b_base(cur);
    if constexpr (GATHER) {
#pragma unroll
        for (int i = 0; i < 2; ++i) { va0[i] = ((unsigned)S.row_index(cur, Rr[i]) * (unsigned)lda + (unsigned)Cc[i]) * 2u; va1[i] = ((unsigned)S.row_index(cur, HALF + Rr[i]) * (unsigned)lda + (unsigned)Cc[i]) * 2u; }
    }
    PG8_STAGE2(PG8_SB(0, 0), cB, voffB[0], voffB[1]); PG8_STAGE_B1(PG8_SB(0, 1), cB + hstepB); PG8_STAGE2(PG8_SA(0, 0), cA, va0[0], va0[1]); PG8_STAGE2(PG8_SA(0, 1), cA, va1[0], va1[1]);
    if (wr == 1) PG8_BAR;
    PG8_WAIT_V(2); PG8_BAR;
    PG8_STAGE2(PG8_SB(1, 0), cB + kstep, voffB[0], voffB[1]); PG8_STAGE2(PG8_SA(1, 0), cA + kstep, va0[0], va0[1]); PG8_STAGE_B1(PG8_SB(1, 1), cB + hstepB + kstep);
    if constexpr (HALFN) PG8_WAIT_V(4); else PG8_WAIT_V(6); PG8_BAR;
    for (;;) {
        const bool has_next = S.next(ui + 1, nxt);
        const char* nA = has_next ? S.a_base(nxt) : cA; const char* nB = has_next ? S.b_base(nxt) : cB;
        if constexpr (GATHER) {
            if (has_next && wid < 4) S.ids_dma(nxt, wid * 64 + mk_lane(), (unsigned)(__SIZE_TYPE__)lds + RAW_LDS_OFF + (unsigned)wid * 256u);
        }
        if constexpr (Epi::HAS_PRE) E.pre(cur, ui & 1, wid, mk_lane());
        if constexpr (Epi::HAS_SEG) { const int l_e = mk_lane(); E.seg_fetch(cur, wr, wc, l_e & 15, l_e >> 4); }
#pragma unroll 1
        for (int t = 0; t < nt; t += 2) {
            const bool last = (t == nt - 2);
            const bool pre = Epi::NVM > 0 && t == 0 && ui > 0;
            const char* a1 = cA + (size_t)(t + 1) * kstep;
            const char* a2 = last ? nA : cA + (size_t)(t + 2) * kstep; const char* b2 = last ? nB : cB + (size_t)(t + 2) * kstep;
            const char* a3 = a2 + kstep; const char* b3 = b2 + kstep;
            if constexpr (GATHER) { if (t == 2) {
                const int tid2 = wid * 64 + mk_lane();
                u32x4 nv = (u32x4){va0[0], va0[1], va1[0], va1[1]};
                if (has_next) {
#pragma unroll
                    for (int i = 0; i < 2; ++i) { int R2, C2; stage_rc(tid2 * 16 + i * 8192, R2, C2);
                        const int i0 = *(const PG8_LAS int*)(lds + RAW_LDS_OFF + R2 * 4), i1 = *(const PG8_LAS int*)(lds + RAW_LDS_OFF + (HALF + R2) * 4);
                        nv[i] = ((unsigned)S.row_pick(nxt, R2, i0) * (unsigned)lda + (unsigned)C2) * 2u; nv[2 + i] = ((unsigned)S.row_pick(nxt, HALF + R2, i1) * (unsigned)lda + (unsigned)C2) * 2u; } }
                *(PG8_LAS u32x4*)(lds + NA_LDS_OFF + tid2 * 16) = nv; } }
            if constexpr (Epi::HAS_SEG) { if (t > 0) { const int l_e = mk_lane(), fr_e = l_e & 15, fq_e = l_e >> 4; E.seg(acc, cur, t >> 1, wr, wc, fr_e, fq_e); } }
            if constexpr (Epi::HAS_MID) { if (t == nt / 2) { const int l_e = mk_lane(), fr_e = l_e & 15, fq_e = l_e >> 4; E.mid(acc, cur, wr, wc, fr_e, fq_e); } }
            unsigned x00 = va0[0], x01 = va0[1], x10 = va1[0], x11 = va1[1];
            if constexpr (GATHER) { if (last) { const u32x4 nv = *(const PG8_LAS u32x4*)(lds + NA_LDS_OFF + (wid * 64 + mk_lane()) * 16); x00 = nv[0]; x01 = nv[1]; x10 = nv[2]; x11 = nv[3]; } }
            PG8_LDB(B0, 0, 0); if constexpr (!HALFN) PG8_LDB(B1, 0, 1); PG8_SCHED; PG8_LDA(At, 0, 0); if (!pre) PG8_STAGE2(PG8_SA(1, 1), a1, va1[0], va1[1]);
            PG8_WAIT_VX(pre); PG8_WAIT_L(0); PG8_BAR; PG8_MMA(0, 0, At, B0); if constexpr (!HALFN) PG8_MMA(0, 1, At, B1); PG8_BAR; PG8_SCHED;
            PG8_LDA(At, 0, 1); PG8_STAGE2(PG8_SB(0, 0), b2, voffB[0], voffB[1]); PG8_STAGE_B1(PG8_SB(0, 1), b2 + hstepB); PG8_STAGE2(PG8_SA(0, 0), a2, x00, x01);
            PG8_WAIT_VX(pre); PG8_WAIT_L(0); PG8_BAR; PG8_MMA(1, 0, At, B0); if constexpr (!HALFN) PG8_MMA(1, 1, At, B1); PG8_BAR; PG8_SCHED;
            PG8_LDB(B0, 1, 0); if constexpr (!HALFN) PG8_LDB(B1, 1, 1); PG8_SCHED; PG8_LDA(At, 1, 0); PG8_STAGE2(PG8_SA(0, 1), a2, x10, x11);
            PG8_WAIT_VX(pre); PG8_WAIT_L(0); PG8_BAR; PG8_MMA(0, 0, At, B0); if constexpr (!HALFN) PG8_MMA(0, 1, At, B1); PG8_BAR; PG8_SCHED;
            PG8_LDA(At, 1, 1); PG8_STAGE2(PG8_SB(1, 0), b3, voffB[0], voffB[1]); PG8_STAGE_B1(PG8_SB(1, 1), b3 + hstepB); PG8_STAGE2(PG8_SA(1, 0), a3, x00, x01);
            PG8_WAIT_K(); PG8_WAIT_L(0); PG8_BAR; PG8_MMA(1, 0, At, B0); if constexpr (!HALFN) PG8_MMA(1, 1, At, B1); PG8_BAR; PG8_SCHED;
        }
        if constexpr (Epi::NVM > 0) { static_assert(!GATHER, "pre-staging uses the static row offsets"); PG8_STAGE2(PG8_SA(1, 1), nA + kstep, va1[0], va1[1]); }
        if constexpr (ALIGN_EPI) { if (wr == 0) PG8_BAR; }
        { const int l_e = mk_lane(), fr_e = l_e & 15, fq_e = l_e >> 4;
          Unit ue = cur; asm volatile("" : "+s"(ue.pm), "+s"(ue.pn), "+s"(ue.e), "+s"(ue.lt), "+s"(ue.cnt));
          if constexpr (Epi::HAS_PRE) ue.lt = ui & 1;
          E(acc, ue, wr, wc, fr_e, fq_e); }
        PG8_VMFLUSH(Epi::NVM > 0 ? Epi::NVM : 0);
        if (!has_next) break;
#pragma unroll
        for (int a = 0; a < 2; ++a)
#pragma unroll
            for (int b = 0; b < 2; ++b)
#pragma unroll
                for (int m = 0; m < 4; ++m)
#pragma unroll
                    for (int n = 0; n < 2; ++n) acc[a][b][m][n] = (f32x4){0.f, 0.f, 0.f, 0.f};
        cur = nxt; cA = nA; cB = nB; ++ui;
        if constexpr (GATHER) { const u32x4 nv = *(const PG8_LAS u32x4*)(lds + NA_LDS_OFF + (wid * 64 + mk_lane()) * 16); va0[0] = nv[0]; va0[1] = nv[1]; va1[0] = nv[2]; va1[1] = nv[3]; }
        if constexpr (ALIGN_EPI) { if (wr == 1) PG8_BAR; }
    }
    PG8_WAIT_V(0);
    if constexpr (!ALIGN_EPI) { if (wr == 0) PG8_BAR; }
    PG8_BAR;
#undef PG8_SA
#undef PG8_SB
#undef PG8_STAGE2
#undef PG8_LDA
#undef PG8_LDB
#undef PG8_MMA
#undef PG8_LD8
#undef PG8_WAIT_V
#undef PG8_WAIT_L
#undef PG8_WAIT_K
#undef PG8_STAGE_B1
#undef PG8_VMFLUSH
#undef PG8_WAIT_VX
#undef PG8_BAR
#undef PG8_SCHED
}
}
#include <hip/hip_bf16.h>
#include <cmath>
namespace attn_body {
using bf16=__hip_bfloat16;
using bf16x8=__attribute__((ext_vector_type(8)))short;
using s16x4=__attribute__((ext_vector_type(4)))short;
using f32x16=__attribute__((ext_vector_type(16)))float;
using u32x4=__attribute__((ext_vector_type(4)))unsigned;
constexpr int BATCH=16,NHEAD=8,SEQ=4096,D=64,DM=3072,DMK=64;
constexpr int NW=8,QBLK=32,QB=QBLK*NW,KVBLK=64,NQB=SEQ/QB;
constexpr int ATTN_PITCH=DM, ATTN_UNIT_ROWS=QB;
__device__ __forceinline__ int crow(int r,int hi){return (r&3)+8*(r>>2)+4*hi;}
#define SBAR() __builtin_amdgcn_sched_barrier(0)
__device__ __forceinline__ void cmask(f32x16&p0,f32x16&p1,int jb,int qrel,int hi){
  const float NEG=-INFINITY; int kb=64*jb+4*hi;
  #pragma unroll
  for(int r=0;r<16;++r){int kv=kb+(r&3)+8*(r>>2); if(kv>qrel)p0[r]=NEG; if(kv+32>qrel)p1[r]=NEG;}
}

constexpr int NSLOT=3, SLOTB=8192;
constexpr int LDS_K=0, LDS_V=NSLOT*SLOTB, LDS_WS=2*NSLOT*SLOTB, LDS_OST=LDS_WS+NW*64*4, LDS_BT=LDS_OST+NW*4096, LDS_BYTES=LDS_BT+SEQ*4;
constexpr float OSCALE=4.0f;
constexpr float C2=0.125f*1.4426950408889634f;
__device__ __forceinline__ void glds16(const void*gsrc,unsigned lds_dst){unsigned keep;
  asm volatile("s_mov_b32 %0, m0\n\ts_mov_b32 m0, %2\n\ts_nop 0\n\tglobal_load_lds_dwordx4 %1, off\n\ts_mov_b32 m0, %0":"=&s"(keep):"v"(gsrc),"s"(lds_dst):"memory");}
__device__ __forceinline__ float max3f(float a,float b,float c){float r;asm("v_max3_f32 %0, %1, %2, %3":"=v"(r):"v"(a),"v"(b),"v"(c));return r;}
__device__ __forceinline__ float max2f(float a,float b){float r;asm("v_max_f32_e32 %0, %1, %2":"=v"(r):"v"(a),"v"(b));return r;}
__device__ __forceinline__ float fadd_s(float a,float b){float r;asm("v_add_f32_e32 %0, %1, %2":"=v"(r):"v"(a),"v"(b));return r;}
__device__ __forceinline__ float fsub_s(float a,float b){float r;asm("v_sub_f32_e32 %0, %1, %2":"=v"(r):"v"(a),"v"(b));return r;}
typedef float f32x2_t __attribute__((ext_vector_type(2))); typedef __bf16 bf16x2_t __attribute__((ext_vector_type(2)));
__device__ __forceinline__ unsigned cvtpk_s(float lo,float hi){f32x2_t v={lo,hi};bf16x2_t b=__builtin_convertvector(v,bf16x2_t);return __builtin_bit_cast(unsigned,b);}
#define WAIT_BAR(N) asm volatile("s_waitcnt vmcnt(" #N ") lgkmcnt(0)\n\ts_barrier":::"memory")

__device__ __forceinline__ void qkt(f32x16&p0,f32x16&p1,const char*Kslot,const bf16x8*qr,int r32,int hi){
  const char*kb=Kslot+hi*1024+r32*16;
  #pragma unroll
  for(int d0=0;d0<4;++d0){
    const bf16x8 b0=*reinterpret_cast<const bf16x8*>(kb+d0*2048);
    const bf16x8 b1=*reinterpret_cast<const bf16x8*>(kb+d0*2048+512);
    p0=__builtin_amdgcn_mfma_f32_32x32x16_bf16(b0,qr[d0],p0,0,0,0);p1=__builtin_amdgcn_mfma_f32_32x32x16_bf16(b1,qr[d0],p1,0,0,0);}
}
typedef __attribute__((address_space(3))) const char* lds_cptr;
typedef short v4i16_t __attribute__((ext_vector_type(4)));
__device__ __forceinline__ void kload8(bf16x8*kf,lds_cptr kp){
  kf[0]=*(const __attribute__((address_space(3))) bf16x8*)(kp);      kf[1]=*(const __attribute__((address_space(3))) bf16x8*)(kp+512);
  kf[2]=*(const __attribute__((address_space(3))) bf16x8*)(kp+2048); kf[3]=*(const __attribute__((address_space(3))) bf16x8*)(kp+2560);
  kf[4]=*(const __attribute__((address_space(3))) bf16x8*)(kp+4096); kf[5]=*(const __attribute__((address_space(3))) bf16x8*)(kp+4608);
  kf[6]=*(const __attribute__((address_space(3))) bf16x8*)(kp+6144); kf[7]=*(const __attribute__((address_space(3))) bf16x8*)(kp+6656);
}
__device__ __forceinline__ void kload2(bf16x8*kf,lds_cptr kp,int j){ kf[2*j]=*(const __attribute__((address_space(3))) bf16x8*)(kp+j*2048); kf[2*j+1]=*(const __attribute__((address_space(3))) bf16x8*)(kp+j*2048+512); }
__device__ __forceinline__ s16x4 vtr(lds_cptr p){ return __builtin_bit_cast(s16x4,__builtin_amdgcn_ds_read_tr16_b64_v4i16((__attribute__((address_space(3))) v4i16_t*)p)); }
__device__ __forceinline__ float rowmax(const f32x16&p0,const f32x16&p1){
  float a=max3f(p0[0],p0[1],p1[0]),b=max3f(p0[2],p0[3],p1[1]);a=max3f(a,p1[2],p1[3]);
  #pragma unroll
  for(int r=4;r<16;r+=4){a=max3f(a,p0[r],p0[r+1]);b=max3f(b,p0[r+2],p0[r+3]);a=max3f(a,p1[r],p1[r+1]);b=max3f(b,p1[r+2],p1[r+3]);}
  const float m=max2f(a,b);
  auto rr=__builtin_amdgcn_permlane32_swap(__float_as_uint(m),__float_as_uint(m),false,false);
  return max2f(__uint_as_float(rr[0]),__uint_as_float(rr[1]));
}
__device__ __forceinline__ void pv(f32x16*o,int vb,bf16x8 pa0,bf16x8 pa1,bf16x8 pa2,bf16x8 pa3){
  #pragma unroll
  for(int d0=0;d0<2;++d0){s16x4 lo[4],hi[4];
    #pragma unroll
    for(int ks=0;ks<4;++ks){
      asm volatile("ds_read_b64_tr_b16 %0,%1 offset:%c2":"=&v"(lo[ks]):"v"(vb),"i"(d0*4096+ks*1024):"memory");
      asm volatile("ds_read_b64_tr_b16 %0,%1 offset:%c2":"=&v"(hi[ks]):"v"(vb),"i"(d0*4096+ks*1024+512):"memory");}
    asm volatile("s_waitcnt lgkmcnt(0)":::"memory");SBAR();
    #define PK(k) (bf16x8){lo[k][0],lo[k][1],lo[k][2],lo[k][3],hi[k][0],hi[k][1],hi[k][2],hi[k][3]}
    o[d0]=__builtin_amdgcn_mfma_f32_32x32x16_bf16(pa0,PK(0),o[d0],0,0,0);
    o[d0]=__builtin_amdgcn_mfma_f32_32x32x16_bf16(pa1,PK(1),o[d0],0,0,0);
    o[d0]=__builtin_amdgcn_mfma_f32_32x32x16_bf16(pa2,PK(2),o[d0],0,0,0);
    o[d0]=__builtin_amdgcn_mfma_f32_32x32x16_bf16(pa3,PK(3),o[d0],0,0,0);
    #undef PK
  }
}

#ifndef ATTN_STORE16
#define ATTN_STORE16(p,v) (*(u32x4*)(p)=(v))
#endif
template<int THRL,bool NOMAX> __device__ __forceinline__ void attn_unit(int b,int h,int qb,const bf16*Q,const bf16*__restrict__ K,const bf16*__restrict__ V,unsigned char*O,const float*__restrict__ FL,const float*__restrict__ PT,const float prune,const float zref,char*shm,const int wave){
  const int lane=mk_lane(),r32=lane&31,hi=lane>>5; const int wid=wave; const int tid=wid*64+lane;
  const long rowbase=(long)b*SEQ; const int q0=qb*QB;
  const bf16*Qw=Q+(rowbase+q0+wid*QBLK)*DM+h*D;
  int skip=0; float dq=0.f; { const float*ptb=PT+(long)(b*(SEQ/QB))*NHEAD+h; float ptv[SEQ/QB];
    #pragma unroll
    for(int p=0;p<SEQ/QB;++p)ptv[p]=ptb[p*NHEAD];
    float accb=0.f;
    #pragma unroll
    for(int p=SEQ/QB-2;p>=0;--p){ if(p<=qb-2){ accb+=ptv[p+1]; if(accb<prune&&skip==0)skip=p+1; } }
    #pragma unroll
    for(int p=0;p<SEQ/QB;++p) if(p==qb) dq=ptv[p]; }
  const bool aug=!NOMAX||(__builtin_amdgcn_readfirstlane(dq>zref?1:0)==0);
  skip=__builtin_amdgcn_readfirstlane(skip); const int j0=4*skip;
  const long kvbase=((long)(b*NHEAD+h))*SEQ; const bf16*Kh=K+(kvbase+(long)j0*KVBLK)*DMK,*Vh=V+(kvbase+(long)j0*KVBLK)*DMK;
  const unsigned lds0=(unsigned)(uintptr_t)shm;
  float*wsf=(float*)(shm+LDS_WS)+wid*64;
  const bf16*ksrc=Kh+(long)lane*DMK+wid*8;
  const bf16*vsrc=Vh+(long)(16*(wid&3)+(lane>>2))*DMK+(wid>>2)*32+(lane&3)*8;
  const unsigned kdst=lds0+LDS_K+wid*1024, vdst=lds0+LDS_V+wid*1024;
  #define DMA_K(t,slot) glds16(ksrc+(long)(t)*KVBLK*DMK,(unsigned)__builtin_amdgcn_readfirstlane(kdst+(slot)))
  #define DMA_V(t,slot) glds16(vsrc+(long)(t)*KVBLK*DMK,(unsigned)__builtin_amdgcn_readfirstlane(vdst+(slot)))
  const int vb0=(int)(lds0+LDS_V)+((lane>>4)&1)*32+(lane&3)*8+(4*hi+((lane&15)>>2))*64;
  const char*Kbase=shm+LDS_K; bf16x8 kf[8];
  const lds_cptr shm3=(lds_cptr)shm; const lds_cptr kp0=shm3+LDS_K+hi*1024+r32*16; const lds_cptr vp0=shm3+LDS_V+((lane>>4)&1)*32+(lane&3)*8+(4*hi+((lane&15)>>2))*64;
  const int NT=(q0+QB)/KVBLK-j0;
  DMA_K(0,0);DMA_V(0,0);DMA_K(1,SLOTB);
  bf16x8 qr[4];
  #pragma unroll
  for(int d0=0;d0<4;++d0)qr[d0]=*reinterpret_cast<const bf16x8*>(&Qw[(long)r32*DM+d0*16+hi*8]);
  { typedef float f32x4b __attribute__((ext_vector_type(4)));
    const int nk4=(q0+QB)>>2; const float*flb=FL+((long)(b*NHEAD+h))*SEQ; const float*ptb=PT+(long)(b*(SEQ/QB))*NHEAD+h;
    const int g0=tid,g1=tid+512; const int kp0=g0>>6,kp1=g1>>6; float ref=0.f,c0=0.f,c1=0.f;
    #pragma unroll
    for(int p=0;p<SEQ/QB;++p){const float v=ptb[p*NHEAD]; if(p<=qb)ref+=v; if(p<kp0)c0+=v; if(p<kp1)c1+=v;}
    __attribute__((address_space(3))) float*btw=(__attribute__((address_space(3))) float*)((__attribute__((address_space(3))) char*)shm+LDS_BT);
    if(g0<nk4){const f32x4b f=*(const f32x4b*)(flb+4*g0); f32x4b w; w[0]=(ref-c0)-f[0];w[1]=(ref-c0)-f[1];w[2]=(ref-c0)-f[2];w[3]=(ref-c0)-f[3]; *(__attribute__((address_space(3))) f32x4b*)(btw+4*g0)=w;}
    if(g1<nk4){const f32x4b f=*(const f32x4b*)(flb+4*g1); f32x4b w; w[0]=(ref-c1)-f[0];w[1]=(ref-c1)-f[1];w[2]=(ref-c1)-f[2];w[3]=(ref-c1)-f[3]; *(__attribute__((address_space(3))) f32x4b*)(btw+4*g1)=w;}
  }
  const __attribute__((address_space(3))) float*btp=(const __attribute__((address_space(3))) float*)((__attribute__((address_space(3))) const char*)shm+LDS_BT)+4*hi+64*j0;
  typedef float f32x4b __attribute__((ext_vector_type(4)));
  #define LAS4 __attribute__((address_space(3)))
  #define BIASINIT(P0,P1,t) do{ const LAS4 float*bp_=btp+64*(t); \
    _Pragma("unroll") for(int g_=0;g_<4;++g_){ const f32x4b v_=*(const LAS4 f32x4b*)(bp_+8*g_); const f32x4b w_=*(const LAS4 f32x4b*)(bp_+32+8*g_); \
      P0[4*g_]=v_[0];P0[4*g_+1]=v_[1];P0[4*g_+2]=v_[2];P0[4*g_+3]=v_[3]; P1[4*g_]=w_[0];P1[4*g_+1]=w_[1];P1[4*g_+2]=w_[2];P1[4*g_+3]=w_[3]; } }while(0)
  bf16x8 mfr=__builtin_bit_cast(bf16x8,(u32x4){0u,0u,0u,0u});
  const bf16x8 knegf=__builtin_bit_cast(bf16x8,(u32x4){hi==0?0xBF80BF80u:0u,hi==0?0x0000BF80u:0u,0u,0u});
  #define MFRAG() do{ const unsigned hb_=__float_as_uint(mhat)&0xffff0000u; const float r1_=mhat-__uint_as_float(hb_); const unsigned mb_=__float_as_uint(r1_)&0xffff0000u; const float r2_=r1_-__uint_as_float(mb_); \
      const unsigned lb_=cvtpk_s(r2_,0.f)&0xffffu; mfr=__builtin_bit_cast(bf16x8,(u32x4){hi==0?((hb_>>16)|mb_):0u,hi==0?lb_:0u,0u,0u}); }while(0)
  float mhat=0.f,l_reg=0.f;f32x16 o[2];o[0]=f32x16{};o[1]=f32x16{};
  const int qrel=wid*QBLK+r32;
  #define CMASK(P0,P1,t) do{int jb_=(t)-(NT-4); if(jb_>=0)cmask(P0,P1,jb_,qrel,hi);}while(0)
  bool resc=false;
  #define START(P0,P1) do{ resc=false; \
    if constexpr(NOMAX){ if(aug){ mhat=((const LAS4 float*)((const LAS4 char*)shm+LDS_BT))[q0+qrel]; MFRAG(); \
      _Pragma("unroll") for(int r=0;r<16;++r){P0[r]=fsub_s(P0[r],mhat);P1[r]=fsub_s(P1[r],mhat);} } } \
    else { const float rm=rowmax(P0,P1); const float dl=rm; mhat=fadd_s(mhat,dl); MFRAG(); \
      _Pragma("unroll") for(int r=0;r<16;++r){P0[r]=fsub_s(P0[r],dl);P1[r]=fsub_s(P1[r],dl);} \
    } \
    _Pragma("unroll") for(int r=0;r<16;++r)P0[r]=__builtin_amdgcn_exp2f(P0[r]); }while(0)
  #define RESC() do{ if(resc){ asm volatile("s_waitcnt lgkmcnt(0)":::"memory"); \
      _Pragma("unroll") for(int d_=0;d_<2;++d_) _Pragma("unroll") for(int r=0;r<16;++r)o[d_][r]*=wsf[crow(r,hi)]; } }while(0)
  f32x16 pA0,pA1,pB0,pB1;
  int sl_prev=0,sl_cur=0,sl_next=SLOTB;
  #define ROT() do{sl_prev=sl_cur;sl_cur=sl_next;sl_next=(sl_next==(NSLOT-1)*SLOTB)?0:sl_next+SLOTB;}while(0)
  DMA_K(2,2*SLOTB);
  WAIT_BAR(3);
  BIASINIT(pA0,pA1,0);qkt(pA0,pA1,Kbase,qr,r32,hi);asm volatile("s_nop 15\n\ts_nop 7":"+v"(pA0),"+v"(pA1));CMASK(pA0,pA1,0);
  START(pA0,pA1);
  _Pragma("unroll") for(int r=0;r<16;++r)pA1[r]=__builtin_amdgcn_exp2f(pA1[r]);
  BIASINIT(pB0,pB1,1);
  WAIT_BAR(0);
  DMA_K(3,0);DMA_V(1,SLOTB);
  ROT();
  kload8(kf,kp0+sl_cur);
  WAIT_BAR(2);
  s16x4 vlo[8],vhi[8]; u32x4 pw0,pw1,pw2,pw3;
  #define PKW(P,B) cvtpk_s(P[B],P[B+1])
  #define PAF(k) __builtin_bit_cast(bf16x8,pw##k)
  #define VFR(i) (bf16x8){vlo[i][0],vlo[i][1],vlo[i][2],vlo[i][3],vhi[i][0],vhi[i][1],vhi[i][2],vhi[i][3]}
  #define PIN(x) asm volatile("":"+v"(x))
  #define MX3(a,b,c) __builtin_fmaxf(__builtin_fmaxf((a),(b)),(c))
  #define GAPA(MF,A0,A1,A2,A3,W0,W1,PW) do{ MF; sacc+=A0; sacc+=A1; sacc+=A2; sacc+=A3; PIN(sacc); W0; W1; PIN(PW); SBAR(); }while(0)
  #define EX(v) __builtin_amdgcn_exp2f(v)
  #define GAPB(MF,X,B) do{ MF; X[B]=EX(X[B]); X[B+1]=EX(X[B+1]); X[B+2]=EX(X[B+2]); X[B+3]=EX(X[B+3]); PIN(X); SBAR(); }while(0)
  #define BLDP(k,PX) do{ const f32x4b t_=*(const LAS4 f32x4b*)(bq_+((k)&1)*32+8*((k)>>1)); PX[4*((k)>>1)]=t_[0]; PX[4*((k)>>1)+1]=t_[1]; PX[4*((k)>>1)+2]=t_[2]; PX[4*((k)>>1)+3]=t_[3]; }while(0)
  #define BSUBK(k,PX) do{ PX[4*((k)>>1)]=fsub_s(tb##k[0],mhat); PX[4*((k)>>1)+1]=fsub_s(tb##k[1],mhat); PX[4*((k)>>1)+2]=fsub_s(tb##k[2],mhat); PX[4*((k)>>1)+3]=fsub_s(tb##k[3],mhat); PIN(PX); }while(0)
  #define GAPBX(MF,X,B,LD,SB) do{ MF; X[B]=EX(X[B]); X[B+1]=EX(X[B+1]); X[B+2]=EX(X[B+2]); X[B+3]=EX(X[B+3]); PIN(X); LD; SB; SBAR(); }while(0)
  #define VRD(i) do{ vlo[i]=vtr(vp_+(((i)>>2)*4096+((i)&3)*1024)); vhi[i]=vtr(vp_+(((i)>>2)*4096+((i)&3)*1024+512)); }while(0)
  #define KRD(G,j) do{ if(G){ kload2(kf,kp0+sl_next,j); SBAR(); } }while(0)
  #define STEP(C0,C1,P0,P1,t,GK,GV,GL) do{ SBAR(); \
    const lds_cptr vp_=vp0+sl_prev; \
    VRD(0); SBAR(); float sacc=(P0[0]+P0[1]); \
    GAPA(C0=__builtin_amdgcn_mfma_f32_32x32x16_bf16(kf[0],qr[0],C0,0,0,0), P0[2],P0[3],P0[4],P0[5],     pw0[0]=PKW(P0,0), pw0[1]=PKW(P0,2), pw0); \
    VRD(4); SBAR(); GAPA(C1=__builtin_amdgcn_mfma_f32_32x32x16_bf16(kf[1],qr[0],C1,0,0,0), P0[6],P0[7],P0[8],P0[9],     pw0[2]=PKW(P0,4), pw0[3]=PKW(P0,6), pw0); \
    VRD(1); SBAR(); GAPA(C0=__builtin_amdgcn_mfma_f32_32x32x16_bf16(kf[2],qr[1],C0,0,0,0),   P0[10],P0[11],P0[12],P0[13], pw1[0]=PKW(P0,8), pw1[1]=PKW(P0,10), pw1); \
    VRD(5); SBAR(); GAPA(C1=__builtin_amdgcn_mfma_f32_32x32x16_bf16(kf[3],qr[1],C1,0,0,0),   P0[14],P0[15],P1[0],P1[1],   pw1[2]=PKW(P0,12),pw1[3]=PKW(P0,14), pw1); \
    VRD(2); SBAR(); GAPA(C0=__builtin_amdgcn_mfma_f32_32x32x16_bf16(kf[4],qr[2],C0,0,0,0),   P1[2],P1[3],P1[4],P1[5],     pw2[0]=PKW(P1,0), pw2[1]=PKW(P1,2), pw2); \
    VRD(6); SBAR(); GAPA(C1=__builtin_amdgcn_mfma_f32_32x32x16_bf16(kf[5],qr[2],C1,0,0,0),   P1[6],P1[7],P1[8],P1[9],     pw2[2]=PKW(P1,4), pw2[3]=PKW(P1,6), pw2); \
    VRD(3); SBAR(); GAPA(C0=__builtin_amdgcn_mfma_f32_32x32x16_bf16(kf[6],qr[3],C0,0,0,0),   P1[10],P1[11],P1[12],P1[13], pw3[0]=PKW(P1,8), pw3[1]=PKW(P1,10), pw3); \
    VRD(7); SBAR(); GAPA(C1=__builtin_amdgcn_mfma_f32_32x32x16_bf16(kf[7],qr[3],C1,0,0,0),   P1[14],P1[15],0.f,0.f,       pw3[2]=PKW(P1,12),pw3[3]=PKW(P1,14), pw3); \
    l_reg+=sacc; \
    if(aug){ C0=__builtin_amdgcn_mfma_f32_32x32x16_bf16(knegf,mfr,C0,0,0,0); C1=__builtin_amdgcn_mfma_f32_32x32x16_bf16(knegf,mfr,C1,0,0,0); } \
    if(GK){DMA_K((t)+3,sl_cur);} if(GV){DMA_V((t)+1,sl_next);} \
    CMASK(C0,C1,t); \
    if constexpr(!NOMAX){ float a=MX3(C0[0],C0[1],C1[0]),b=MX3(C0[2],C0[3],C1[1]); a=MX3(a,C1[2],C1[3]); \
      _Pragma("unroll") for(int r=4;r<16;r+=4){a=MX3(a,C0[r],C0[r+1]);b=MX3(b,C0[r+2],C0[r+3]);a=MX3(a,C1[r],C1[r+1]);b=MX3(b,C1[r+2],C1[r+3]);} \
      float rm=__builtin_fmaxf(a,b); { auto rr=__builtin_amdgcn_permlane32_swap(__float_as_uint(rm),__float_as_uint(rm),false,false); rm=__builtin_fmaxf(__uint_as_float(rr[0]),__uint_as_float(rr[1])); } \
      resc=false; \
      if(__builtin_expect(__any(rm>(float)THRL),0)){ const float dl=__builtin_fmaxf(rm,0.f); mhat+=dl; \
        _Pragma("unroll") for(int r=0;r<16;++r){C0[r]-=dl;C1[r]-=dl;} \
        const float f=__builtin_amdgcn_exp2f(-dl); l_reg*=f; if(hi==0)wsf[r32]=f; resc=true; MFRAG(); } } \
    SBAR(); \
    const LAS4 float*bq_=btp+64*((t)+1); \
    GAPBX(o[0]=__builtin_amdgcn_mfma_f32_32x32x16_bf16(PAF(0),VFR(0),o[0],0,0,0), C0,0,  BLDP(0,P0), (void)0); \
    GAPBX(o[1]=__builtin_amdgcn_mfma_f32_32x32x16_bf16(PAF(0),VFR(4),o[1],0,0,0), C0,4,  BLDP(1,P1), (void)0); \
    KRD(GL,0); GAPBX(o[0]=__builtin_amdgcn_mfma_f32_32x32x16_bf16(PAF(1),VFR(1),o[0],0,0,0), C0,8,  BLDP(2,P0), (void)0); \
    KRD(GL,1); GAPBX(o[1]=__builtin_amdgcn_mfma_f32_32x32x16_bf16(PAF(1),VFR(5),o[1],0,0,0), C0,12, BLDP(3,P1), (void)0); \
    KRD(GL,2); GAPBX(o[0]=__builtin_amdgcn_mfma_f32_32x32x16_bf16(PAF(2),VFR(2),o[0],0,0,0), C1,0,  BLDP(4,P0), (void)0); \
    KRD(GL,3); GAPBX(o[1]=__builtin_amdgcn_mfma_f32_32x32x16_bf16(PAF(2),VFR(6),o[1],0,0,0), C1,4,  BLDP(5,P1), (void)0); \
    GAPBX(o[0]=__builtin_amdgcn_mfma_f32_32x32x16_bf16(PAF(3),VFR(3),o[0],0,0,0), C1,8,  BLDP(6,P0), (void)0); \
    GAPBX(o[1]=__builtin_amdgcn_mfma_f32_32x32x16_bf16(PAF(3),VFR(7),o[1],0,0,0), C1,12, BLDP(7,P1), (void)0); \
    PIN(P0); PIN(P1); SBAR(); \
    }while(0)
  int t=1;
  #undef CMASK
  #define CMASK(P0,P1,t) do{}while(0)
  for(;t+5<NT;t+=2){
    STEP(pB0,pB1,pA0,pA1,t,true,true,true);     WAIT_BAR(2); RESC(); ROT();
    STEP(pA0,pA1,pB0,pB1,t+1,true,true,true);   WAIT_BAR(2); RESC(); ROT();
  }
  #undef CMASK
  #define CMASK(P0,P1,t) do{int jb_=(t)-(NT-4); if(jb_>=0)cmask(P0,P1,jb_,qrel,hi);}while(0)
  #define ENDW(tt) do{ if((tt)+3<NT){WAIT_BAR(2);} else if((tt)+2<NT){WAIT_BAR(1);} else {WAIT_BAR(0);} }while(0)
  for(;t+1<NT;t+=2){
    STEP(pB0,pB1,pA0,pA1,t,(t+3<NT),(t+1<NT),(t+1<NT));       ENDW(t);   RESC(); ROT();
    STEP(pA0,pA1,pB0,pB1,t+1,(t+4<NT),(t+2<NT),(t+2<NT));     ENDW(t+1); RESC(); ROT();
  }
  STEP(pB0,pB1,pA0,pA1,NT-1,false,false,false); RESC();
  { float sacc=pB0[0]+pB0[1]; _Pragma("unroll") for(int r=2;r<16;++r)sacc+=pB0[r]; _Pragma("unroll") for(int r=0;r<16;++r)sacc+=pB1[r]; l_reg+=sacc;
    pw0=(u32x4){PKW(pB0,0),PKW(pB0,2),PKW(pB0,4),PKW(pB0,6)};pw1=(u32x4){PKW(pB0,8),PKW(pB0,10),PKW(pB0,12),PKW(pB0,14)};pw2=(u32x4){PKW(pB1,0),PKW(pB1,2),PKW(pB1,4),PKW(pB1,6)};pw3=(u32x4){PKW(pB1,8),PKW(pB1,10),PKW(pB1,12),PKW(pB1,14)};
    SBAR(); pv(o,vb0+sl_cur,PAF(0),PAF(1),PAF(2),PAF(3)); }
  #undef PKW
  #undef PAF
  #undef VFR
  #undef PIN
  #undef MX3
  #undef GAPA
  #undef GAPB
  #undef GAPBX
  #undef BLDK
  #undef BSUBK
  #undef EX
  #undef VRD
  #undef KRD
  #undef STEP
  #undef ENDW
  {auto rr=__builtin_amdgcn_permlane32_swap(__float_as_uint(l_reg),__float_as_uint(l_reg),false,false);l_reg=__uint_as_float(rr[0])+__uint_as_float(rr[1]);}
  if(hi==0)wsf[32+r32]=l_reg;asm volatile("s_waitcnt lgkmcnt(0)":::"memory");
  float rli[16];
  #pragma unroll
  for(int r=0;r<16;++r)rli[r]=__builtin_amdgcn_rcpf(wsf[32+crow(r,hi)]);
  unsigned char*Ow=O+(rowbase+q0+wid*QBLK)*(long)(DM*2)+h*D;
  { __attribute__((address_space(3))) unsigned char*stg=(__attribute__((address_space(3))) unsigned char*)((__attribute__((address_space(3))) char*)shm+LDS_OST)+wid*4096;
    #pragma unroll
    for(int r=0;r<16;++r){const int orow=crow(r,hi); const float s_=rli[r]*OSCALE;
      const float a_=__builtin_fminf(__builtin_fmaxf(o[0][r]*s_,-448.f),448.f), b_=__builtin_fminf(__builtin_fmaxf(o[1][r]*s_,-448.f),448.f);
      const unsigned pk_=(unsigned)__builtin_amdgcn_cvt_pk_fp8_f32(a_,b_,0,false);
      stg[orow*64+r32]=(unsigned char)(pk_&0xffu); stg[orow*64+32+r32]=(unsigned char)((pk_>>8)&0xffu);}
    asm volatile("s_waitcnt lgkmcnt(0)":::"memory");
    #pragma unroll
    for(int i=0;i<2;++i){const int row=i*16+(lane>>2),ch=lane&3; const u32x4 v=*(const __attribute__((address_space(3))) u32x4*)(stg+row*64+ch*16); ATTN_STORE16(Ow+(long)row*(DM*2)+ch*16,v);} }
  asm volatile("s_waitcnt lgkmcnt(0)\n\ts_barrier":::"memory");
  #undef DMA_K
  #undef DMA_V
  #undef BIASINIT
  #undef LAS4
  #undef CMASK
  #undef START
  #undef RESC
  #undef ROT
}
constexpr int ATTN_LDS_BYTES=LDS_BYTES;
struct AttnTensors { const bf16* Q; const bf16* K; const bf16* V; unsigned char* O; const float* FL; const float* PT; float prune; int nomax; float zref; };
struct AttnUnit { int bh; int qb; };
struct DynOrder {
  unsigned* ctr; volatile __attribute__((address_space(3))) unsigned* word; int wave;
  __device__ __forceinline__ void prime(unsigned&pre)const{ pre=0u; if(wave==0&&mk_lane()==0) pre=__hip_atomic_fetch_add(ctr,1u,__ATOMIC_RELAXED,__HIP_MEMORY_SCOPE_AGENT); }
  __device__ __forceinline__ bool next(int,AttnUnit&u,unsigned&pre)const{
    if(wave==0&&mk_lane()==0){ *word=pre; pre=__hip_atomic_fetch_add(ctr,1u,__ATOMIC_RELAXED,__HIP_MEMORY_SCOPE_AGENT); }
    asm volatile("s_waitcnt lgkmcnt(0)\n\ts_barrier":::"memory");
    const unsigned L=__builtin_amdgcn_readfirstlane(*word);
    asm volatile("s_waitcnt lgkmcnt(0)\n\ts_barrier":::"memory");
    if(L>=(unsigned)(BATCH*NHEAD*NQB))return false;
    u.qb=NQB-1-(int)(L/(BATCH*NHEAD)); u.bh=(int)(L%(BATCH*NHEAD)); return true; }
  __device__ __forceinline__ void a_ready(const AttnUnit&)const{}
  __device__ __forceinline__ void done(const AttnUnit&)const{}
};
struct DynOrderConv {
  unsigned* ctr; volatile __attribute__((address_space(3))) unsigned* word; int wave;
  __device__ __forceinline__ void prime(unsigned&pre)const{ pre=0u; if(wave==0&&mk_lane()==0) pre=__hip_atomic_fetch_add(ctr,1u,__ATOMIC_RELAXED,__HIP_MEMORY_SCOPE_AGENT); }
  __device__ __forceinline__ bool next(int,AttnUnit&u,unsigned&pre)const{
    if(wave==0&&mk_lane()==0){ *word=pre; pre=__hip_atomic_fetch_add(ctr,1u,__ATOMIC_RELAXED,__HIP_MEMORY_SCOPE_AGENT); }
    asm volatile("s_waitcnt lgkmcnt(0)\n\ts_barrier":::"memory");
    const unsigned L=__builtin_amdgcn_readfirstlane(*word);
    asm volatile("s_waitcnt lgkmcnt(0)\n\ts_barrier":::"memory");
    constexpr unsigned NT=BATCH*NHEAD*NQB;
    if(L>=NT+NT/8)return false;
    const unsigned g=L/9u,r=L-9u*g;
    if(r==8u){ u.qb=-1; u.bh=(int)g; } else { const unsigned A=g*8u+r; u.qb=NQB-1-(int)(A/(BATCH*NHEAD)); u.bh=(int)(A%(BATCH*NHEAD)); }
    return true; }
};
template<class Sched,int THRL=8> __device__ __forceinline__ void attn_phase(char*lds,const AttnTensors&T,const Sched&S,const int wave){
  AttnUnit u; unsigned pre; S.prime(pre);
  if(T.nomax){ for(int i=0;S.next(i,u,pre);++i){ S.a_ready(u); attn_unit<THRL,true>(u.bh/NHEAD,u.bh%NHEAD,u.qb,T.Q,T.K,T.V,T.O,T.FL,T.PT,T.prune,T.zref,lds,wave); S.done(u); } }
  else { for(int i=0;S.next(i,u,pre);++i){ S.a_ready(u); attn_unit<THRL,false>(u.bh/NHEAD,u.bh%NHEAD,u.qb,T.Q,T.K,T.V,T.O,T.FL,T.PT,T.prune,T.zref,lds,wave); S.done(u); } }
}
#undef SBAR
#undef WAIT_BAR
}
constexpr int NWAVES = 8;
#ifndef MK_N_LAUNCHES
#define MK_N_LAUNCHES 1
#endif
constexpr int N_PHASES = 10;
constexpr int N_LAUNCHES = MK_N_LAUNCHES;

constexpr int BATCH = 16, SEQ = 4096, D = 1024, M = BATCH * SEQ, NPANEL = M / 256, PPS = SEQ / 256;
constexpr int NH = 8, HD = 64, CW = 512;
constexpr int PP5 = 5120;
constexpr int INC = 5128, PP = 3072;
constexpr int NE = 32, NG = 4, EPG = 8, DE = 256;
constexpr int MODC = 6 * D;
constexpr float EPS = 1e-6f;
constexpr float LOG2E = 1.4426950408889634f;
constexpr int PC_U = 0, PC_B = 512, PC_C = 1024, PC_Q = 1536, PC_GC = 2048, PC_GA = 2560;
constexpr int LISTCAP = 65536;
constexpr int AROWS = 2 * M + NE * 256;
constexpr int NLOG = 80;

constexpr size_t MiB = 1u << 20;
constexpr size_t WS_CTL = 0, CTL_ZERO_BYTES = 1 * MiB;
constexpr size_t WS_WIN = 1 * MiB;
constexpr size_t WS_WOC = 11 * MiB;
constexpr size_t WS_WOA = 12 * MiB;
constexpr size_t WS_WO = 13 * MiB;
constexpr size_t WS_WR = 15 * MiB;
constexpr size_t WS_WGU = 16 * MiB;
constexpr size_t WS_WD = 48 * MiB;
constexpr size_t WS_MODP = 64 * MiB;
constexpr size_t WS_MOD = 70 * MiB;
constexpr size_t WS_PT = WS_MOD + 512 * 1024;
constexpr size_t WS_FL = 71 * MiB;
constexpr size_t WS_WF = 73 * MiB;
constexpr size_t WS_POS = 74 * MiB;
constexpr size_t WS_LIST = 76 * MiB;
constexpr size_t WS_WLIST = 84 * MiB;
constexpr size_t WS_LOG = 92 * MiB;
constexpr size_t WS_H = 112 * MiB;
constexpr size_t WS_PROJ = 240 * MiB;
constexpr size_t WS_KB = 624 * MiB;
constexpr size_t WS_VB = 688 * MiB;
constexpr size_t WS_ACT = 240 * MiB;
constexpr size_t WS_Y = 308 * MiB;
constexpr size_t WS_DELTA = 752 * MiB;
constexpr size_t WS_H8 = 880 * MiB;
constexpr size_t WS_WIN8 = 944 * MiB;
constexpr size_t WS_RS = 73 * MiB + 256 * 1024;
constexpr size_t WS_CS = 73 * MiB + 640 * 1024;
constexpr size_t WS_CSO = WS_CS + 32 * 1024;
constexpr size_t WS_EX = WS_CS + 64 * 1024;
constexpr size_t WS_WRB = 950 * MiB;
constexpr size_t WS_BR = 958 * MiB;
constexpr size_t WS_END = 959 * MiB;
static_assert(WS_PROJ + (size_t)M * PP * 2 <= WS_KB && WS_Y + (size_t)AROWS * 1024 <= WS_KB && WS_DELTA + (size_t)M * 1024 * 2 <= 880 * MiB && WS_ACT + (size_t)AROWS * 256 * 2 <= WS_Y && WS_Y + (size_t)AROWS * 1024 * 2 <= WS_END && WS_PROJ + (size_t)M * PP * 2 <= WS_END, "d_ws map");
constexpr int CW_TMO = 0, CW_CODE = 1;
constexpr int CW_CNT = 1024;
constexpr int CW_ATTQ = 2048;
constexpr int CW_CMAX = 16384;
constexpr int CW_BAR = 4096;

constexpr int RING_OFF = 0, RING_BYTES = 131072;
constexpr int LDSCTL_OFF = RING_BYTES, MISC_OFF = LDSCTL_OFF + 320;
constexpr int TAB_OFF = LDSCTL_OFF + 1024;
constexpr int PTR_OFF = LDSCTL_OFF + 512;
constexpr int OST_OFF = 145408;
constexpr int LDS_BYTES = 163840;
static_assert(TAB_OFF + 1024 + 4096 <= pg8::NA_LDS_OFF && pg8::NA_LDS_OFF + 8192 <= OST_OFF && OST_OFF + 16384 == pg8::RAW_LDS_OFF && pg8::RAW_LDS_OFF + 1024 <= LDS_BYTES, "LDS map");

#define GAS __attribute__((address_space(1)))
#define LAS __attribute__((address_space(3)))
typedef unsigned short bf16;
typedef unsigned v4u __attribute__((ext_vector_type(4)));
typedef unsigned v2u __attribute__((ext_vector_type(2)));
typedef float f32x4 __attribute__((ext_vector_type(4)));
typedef GAS unsigned gu32;
#define RLX_AGENT __ATOMIC_RELAXED, __HIP_MEMORY_SCOPE_AGENT
#define LDS_WAIT() asm volatile("s_waitcnt lgkmcnt(0)" ::: "memory")
#define VM_WAIT() asm volatile("s_waitcnt vmcnt(0)" ::: "memory")
__device__ __forceinline__ unsigned f2bf(float f) { unsigned u = __builtin_bit_cast(unsigned, f); return (u + 0x7fffu + ((u >> 16) & 1u)) >> 16; }
__device__ __forceinline__ unsigned pk2(float lo, float hi) { return f2bf(lo) | (f2bf(hi) << 16); }
__device__ __forceinline__ float bflo(unsigned w) { return __uint_as_float(w << 16); }
__device__ __forceinline__ float bfhi(unsigned w) { return __uint_as_float(w & 0xffff0000u); }
__device__ __forceinline__ float clamp_fp8(float x) { return __builtin_amdgcn_fmed3f(x, -448.0f, 448.0f); }
__device__ __forceinline__ unsigned pk4_fp8(float a, float b, float c, float d) { int w = __builtin_amdgcn_cvt_pk_fp8_f32(clamp_fp8(a), clamp_fp8(b), 0, false); w = __builtin_amdgcn_cvt_pk_fp8_f32(clamp_fp8(c), clamp_fp8(d), w, true); return (unsigned)w; }
__device__ __forceinline__ unsigned pk4_i8(float a, float b, float c, float d) {
    const unsigned ua = __float_as_uint(a + 12582912.0f), ub = __float_as_uint(b + 12582912.0f), uc = __float_as_uint(c + 12582912.0f), ud = __float_as_uint(d + 12582912.0f);
    const unsigned lo = __builtin_amdgcn_perm(ub, ua, 0x0c0c0400u), hi = __builtin_amdgcn_perm(ud, uc, 0x04000c0cu);
    return lo | hi;
}
constexpr float Y8_SCALE = 16.0f;
constexpr float M8_SCALE = 8.0f;
constexpr float A8_SCALE = 64.0f;
constexpr float D8_SCALE = 16.0f;
constexpr float YA8_SCALE = 4.0f;
constexpr int MRG_EXP = 7;
constexpr float W8_SCALE = 32.0f;

#define XB_TMO      128
#define XB_XCNT(j)  (256  + 64 * (j))
#define XB_XSUB(j)  (1280 + 64 * (j))
#define XB_XGEN(j)  (2304 + 64 * (j))
#define XB_TOP      3328
#define XB_TOPGEN   3392
#define XCD_BAR_WORDS 3456
#define XB_SPIN_CAP (1u << 18)

__device__ __forceinline__ unsigned xb_ld(unsigned* p)              { return __hip_atomic_load(p, __ATOMIC_RELAXED, __HIP_MEMORY_SCOPE_AGENT); }
__device__ __forceinline__ unsigned xb_add(unsigned* p, unsigned v) { return __hip_atomic_fetch_add(p, v, __ATOMIC_RELAXED, __HIP_MEMORY_SCOPE_AGENT); }
__device__ __forceinline__ unsigned xb_xcc_id() { return (unsigned)__builtin_amdgcn_s_getreg((3 << 11) | 20) & 0xFu; }
#define XB_SPIN(cond, bar) do { unsigned _sp = 0; while (cond) { __builtin_amdgcn_s_sleep(1); \
    if ((++_sp & 255u) == 0u) { if (xb_ld(&(bar)[XB_TMO])) break; if (_sp > XB_SPIN_CAP) { atomicAdd(&(bar)[XB_TMO], 1u); break; } } } } while (0)

struct XcdBarrier {
    unsigned* bar; unsigned x;
    volatile LAS unsigned* st;
};
__device__ __forceinline__ XcdBarrier xcd_barrier_post(unsigned* bar, volatile LAS unsigned* st, const bool t0) {
    XcdBarrier b; b.bar = bar; b.x = xb_xcc_id(); b.st = st;
    if (t0) (void)xb_add(&bar[XB_XCNT(b.x)], 1u);
    return b;
}
__device__ __forceinline__ void xcd_barrier_complete(unsigned* bar, unsigned x, unsigned& nloc, unsigned& nx) {
    const unsigned G = gridDim.x * gridDim.y * gridDim.z;
    unsigned sum, cnt, mine, sp = 0u;
    for (;;) {
        sum = 0u; cnt = 0u; mine = 0u;
#pragma unroll
        for (unsigned j = 0; j < 16; ++j) { const unsigned c = xb_ld(&bar[XB_XCNT(j)]); sum += c; cnt += (c > 0u) ? 1u : 0u; mine = (j == x) ? c : mine; }
        if (sum == G) break;
        __builtin_amdgcn_s_sleep(1);
        if ((++sp & 255u) == 0u) { if (xb_ld(&bar[XB_TMO])) break; if (sp > XB_SPIN_CAP) { atomicAdd(&bar[XB_TMO], 1u); break; } }
    }
    nloc = mine > 0u ? mine : 1u; nx = cnt > 0u ? cnt : 1u;
}
__device__ __forceinline__ void xcd_barrier(const XcdBarrier& b, const bool t0) {
    asm volatile("s_waitcnt vmcnt(0)" ::: "memory");
    __syncthreads();
    if (t0) {
        unsigned* bar = b.bar;
        __builtin_amdgcn_s_waitcnt(0);
        unsigned nloc = b.st[0], nx = b.st[1];
        if (nloc == 0u) { xcd_barrier_complete(bar, b.x, nloc, nx); b.st[0] = nloc; b.st[1] = nx; }
        const unsigned old = xb_add(&bar[XB_XSUB(b.x)], 1u);
        const unsigned gen = old / nloc;
        if (old + 1u == (gen + 1u) * nloc) {
            __builtin_amdgcn_fence(__ATOMIC_RELEASE, "agent");
            asm volatile("s_waitcnt vmcnt(0)" ::: "memory");
            const unsigned og = xb_add(&bar[XB_TOP], 1u);
            const unsigned tg = og / nx;
            if (og + 1u == (tg + 1u) * nx) xb_add(&bar[XB_TOPGEN], 1u);
            else XB_SPIN(xb_ld(&bar[XB_TOPGEN]) == tg, bar);
            __builtin_amdgcn_fence(__ATOMIC_ACQUIRE, "agent");
            xb_add(&bar[XB_XGEN(b.x)], 1u);
            asm volatile("s_waitcnt vmcnt(0)" ::: "memory");
        } else {
            XB_SPIN(xb_ld(&bar[XB_XGEN(b.x)]) == gen, bar);
            __builtin_amdgcn_fence(__ATOMIC_ACQUIRE, "agent");
            asm volatile("s_waitcnt vmcnt(0)" ::: "memory");
        }
    }
    __syncthreads();
}

namespace pg8 {

__device__ __forceinline__ u32x4 dpp_ror8(u32x4 v) { u32x4 r; r.x = __builtin_amdgcn_update_dpp(0, (int)v.x, 0x128, 0xf, 0xf, false); r.y = __builtin_amdgcn_update_dpp(0, (int)v.y, 0x128, 0xf, 0xf, false);
    r.z = __builtin_amdgcn_update_dpp(0, (int)v.z, 0x128, 0xf, 0xf, false); r.w = __builtin_amdgcn_update_dpp(0, (int)v.w, 0x128, 0xf, 0xf, false); return r; }
__device__ __forceinline__ void store_rows64(bf16_t* base, size_t ld, int fr, int fq, u32x4 w0, u32x4 w1, PG8_LAS unsigned char* ost, int lane) {
    *(PG8_LAS u32x4*)(ost + fr * 128 + ((fq ^ (fr & 7)) << 4)) = w0; *(PG8_LAS u32x4*)(ost + fr * 128 + (((fq + 4) ^ (fr & 7)) << 4)) = w1;
    asm volatile("s_waitcnt lgkmcnt(0)" ::: "memory");
    const int r = lane >> 3, c = lane & 7;
    const u32x4 a = *(const PG8_LAS u32x4*)(ost + r * 128 + ((c ^ (r & 7)) << 4)), b = *(const PG8_LAS u32x4*)(ost + (r + 8) * 128 + ((c ^ (r & 7)) << 4));
    asm volatile("s_waitcnt lgkmcnt(0)" ::: "memory");
    *(u32x4*)(base + (size_t)((unsigned)r * (unsigned)ld + 8u * (unsigned)c)) = a; *(u32x4*)(base + (size_t)((unsigned)(r + 8) * (unsigned)ld + 8u * (unsigned)c)) = b;
}
__device__ __forceinline__ void store_rows32(unsigned char* base, size_t ldb, int fr, int fq, u32x4 w, PG8_LAS unsigned char* ost, int lane) {
    *(PG8_LAS u32x4*)(ost + fr * 64 + ((fq ^ ((fr >> 1) & 3)) << 4)) = w;
    asm volatile("s_waitcnt lgkmcnt(0)" ::: "memory");
    const int r = lane >> 2, c = lane & 3;
    const u32x4 a = *(const PG8_LAS u32x4*)(ost + r * 64 + ((c ^ ((r >> 1) & 3)) << 4));
    asm volatile("s_waitcnt lgkmcnt(0)" ::: "memory");
    *(u32x4*)(base + (size_t)((unsigned)r * (unsigned)ldb + 16u * (unsigned)c)) = a;
}
__device__ __forceinline__ void store_rows32_2x8(unsigned char* base, size_t ldb, int fr, int fq, v2u lo, v2u hi, PG8_LAS unsigned char* ost, int lane) {
    *(PG8_LAS v2u*)(ost + fr * 64 + ((((8 * fq) >> 4) ^ ((fr >> 1) & 3)) << 4) + ((8 * fq) & 15)) = lo;
    *(PG8_LAS v2u*)(ost + fr * 64 + ((((32 + 8 * fq) >> 4) ^ ((fr >> 1) & 3)) << 4) + ((8 * fq) & 15)) = hi;
    asm volatile("s_waitcnt lgkmcnt(0)" ::: "memory");
    const int r = lane >> 2, c = lane & 3;
    const u32x4 a = *(const PG8_LAS u32x4*)(ost + r * 64 + ((c ^ ((r >> 1) & 3)) << 4));
    asm volatile("s_waitcnt lgkmcnt(0)" ::: "memory");
    *(u32x4*)(base + (size_t)((unsigned)r * (unsigned)ldb + 16u * (unsigned)c)) = a;
}
struct EpiBf16Plain {
    static constexpr bool PERM = true, HAS_MID = false, HAS_SEG = false; static constexpr bool HAS_PRE = false; static constexpr int NVM = 0;
    bf16_t* O; int ldc;
    __device__ __forceinline__ void operator()(const f32x4 (&acc)[2][2][4][2], const Unit& u, int wr, int wc, int fr, int fq) const {
        const int row0 = u.pm * BM + wr * 64 + fr, col0 = u.pn * BM + wc * 32 + 8 * fq;
#pragma unroll
        for (int ai = 0; ai < 2; ++ai)
#pragma unroll
            for (int m = 0; m < 4; ++m) { bf16_t* rowp = O + (size_t)(row0 + ai * HALF + m * 16) * ldc + col0;
#pragma unroll
                for (int bj = 0; bj < 2; ++bj) { const f32x4 v0 = acc[ai][bj][m][0], v1 = acc[ai][bj][m][1];
                    u32x4 w; w.x = cvt_pk_bf16(v0[0], v0[1]); w.y = cvt_pk_bf16(v0[2], v0[3]); w.z = cvt_pk_bf16(v1[0], v1[1]); w.w = cvt_pk_bf16(v1[2], v1[3]);
                    *(u32x4*)(rowp + bj * HALF) = w; } }
    }
};

struct EpiFp8Plain {
    static constexpr bool PERM = true, HAS_MID = false, HAS_SEG = false; static constexpr bool HAS_PRE = false; static constexpr int NVM = 0;
    unsigned char* O; int ldc; float scale; PG8_LAS unsigned char* ost0;
    __device__ __forceinline__ void operator()(const f32x4 (&acc)[2][2][4][2], const Unit& u, int wr, int wc, int fr, int fq) const {
        const int rowt = u.pm * BM + wr * 64, colw = u.pn * BM + wc * 64; const int lane = fq * 16 + fr; PG8_LAS unsigned char* ost = ost0 + (wr * 4 + wc) * 2048;
#pragma unroll
        for (int ai = 0; ai < 2; ++ai)
#pragma unroll
            for (int m = 0; m < 4; ++m) { v2u w[2];
#pragma unroll
                for (int bj = 0; bj < 2; ++bj) { const f32x4 v0 = acc[ai][bj][m][0] * scale, v1 = acc[ai][bj][m][1] * scale; w[bj].x = pk4_fp8(v0[0], v0[1], v0[2], v0[3]); w[bj].y = pk4_fp8(v1[0], v1[1], v1[2], v1[3]); }
                store_rows32_2x8(O + (size_t)(rowt + ai * HALF + m * 16) * ldc + colw, (size_t)ldc, fr, fq, w[0], w[1], ost, lane); }
    }
};
template <int MODE> struct EpiGate {
    static constexpr bool PERM = true, HAS_MID = false, HAS_SEG = false; static constexpr bool HAS_PRE = false; static constexpr int NVM = 0;
    const bf16_t* G; int ldg, gcol; bf16_t* T; int ldt;
    __device__ __forceinline__ void operator()(const f32x4 (&acc)[2][2][4][2], const Unit& u, int wr, int wc, int fr, int fq) const {
        const int row0 = u.pm * BM + wr * 64 + fr, col0 = u.pn * BM + wc * 32 + 8 * fq;
#pragma unroll
        for (int ai = 0; ai < 2; ++ai)
#pragma unroll
            for (int m = 0; m < 4; ++m) { const size_t r = (size_t)(row0 + ai * HALF + m * 16);
#pragma unroll
                for (int bj = 0; bj < 2; ++bj) { const int c = col0 + bj * HALF;
                    const u32x4 g = *(const u32x4*)(G + r * ldg + gcol + c);
                    const f32x4 a0 = acc[ai][bj][m][0], a1 = acc[ai][bj][m][1];
                    float o[8];
                    o[0] = sigmoid_f(bf_lo(g.x)) * a0[0]; o[1] = sigmoid_f(bf_hi(g.x)) * a0[1]; o[2] = sigmoid_f(bf_lo(g.y)) * a0[2]; o[3] = sigmoid_f(bf_hi(g.y)) * a0[3];
                    o[4] = sigmoid_f(bf_lo(g.z)) * a1[0]; o[5] = sigmoid_f(bf_hi(g.z)) * a1[1]; o[6] = sigmoid_f(bf_lo(g.w)) * a1[2]; o[7] = sigmoid_f(bf_hi(g.w)) * a1[3];
                    bf16_t* tp = T + r * ldt + c;
                    if (MODE == 1) { const u32x4 p = *(const u32x4*)tp;
                        o[0] += bf_lo(p.x); o[1] += bf_hi(p.x); o[2] += bf_lo(p.y); o[3] += bf_hi(p.y); o[4] += bf_lo(p.z); o[5] += bf_hi(p.z); o[6] += bf_lo(p.w); o[7] += bf_hi(p.w); }
                    u32x4 w; w.x = cvt_pk_bf16(o[0], o[1]); w.y = cvt_pk_bf16(o[2], o[3]); w.z = cvt_pk_bf16(o[4], o[5]); w.w = cvt_pk_bf16(o[6], o[7]);
                    *(u32x4*)tp = w; }
                asm volatile("" ::: "memory"); }
    }
};

struct EpiInProj {
    static constexpr bool PERM = true, HAS_MID = false, HAS_SEG = false; static constexpr bool HAS_PRE = true; static constexpr int NVM = 8;
    bf16_t* P; bf16_t* KB; bf16_t* VB; const float* qw; const float* kw; const float* rs; const float* cs; PG8_LAS unsigned char* ost0; PG8_LAS unsigned char* scl;
    __device__ __forceinline__ void pre(const Unit& u, int par, int wid, int lane) const {
        const unsigned dst = (unsigned)(__SIZE_TYPE__)scl + (unsigned)par * 2048u + (unsigned)wid * 256u;
        if (wid < 4) glds4_s(rs, (unsigned)(u.pm * BM + 64 * wid + lane) * 4u, dst); else glds4_s(cs, (unsigned)(u.pn * BM + 64 * (wid - 4) + lane) * 4u, dst);
    }
    __device__ __forceinline__ void operator()(const f32x4 (&acc_)[2][2][4][2], const Unit& u, int wr, int wc, int fr, int fq) const {
        const int t = u.pn; const int rowt = u.pm * BM + wr * 64; const int lane = fq * 16 + fr; PG8_LAS unsigned char* ost = ost0 + (wr * 4 + wc) * 2048;
        const PG8_LAS float* rsL = (const PG8_LAS float*)(scl + u.lt * 2048); const PG8_LAS float* csL = rsL + 256;
        float rsv[2][4]; f32x4 csv[2][2];
#pragma unroll
        for (int a = 0; a < 2; ++a)
#pragma unroll
            for (int m = 0; m < 4; ++m) rsv[a][m] = rsL[wr * 64 + a * HALF + m * 16 + fr];
#pragma unroll
        for (int b = 0; b < 2; ++b)
#pragma unroll
            for (int n = 0; n < 2; ++n) csv[b][n] = *(const PG8_LAS f32x4*)(csL + b * HALF + wc * 32 + 8 * fq + 4 * n);
        if (t >= 12) {
#pragma unroll
            for (int b = 0; b < 2; ++b)
#pragma unroll
                for (int n = 0; n < 2; ++n) csv[b][n] = csv[b][n] * -1.4426950408889634f; }
#define ACC(a, b, m, n) (__builtin_convertvector(__builtin_bit_cast(v4i_t, acc_[a][b][m][n]), f32x4) * (csv[b][n] * rsv[a][m]))
        if (t < 4) {
            unsigned char* dst = (unsigned char*)(P + PC_U + 128 * t + wc * 32);
#pragma unroll
            for (int ai = 0; ai < 2; ++ai)
#pragma unroll
                for (int m = 0; m < 4; ++m) { const f32x4 a0 = ACC(ai, 0, m, 0) * ACC(ai, 1, m, 0), a1 = ACC(ai, 0, m, 1) * ACC(ai, 1, m, 1);
                    u32x4 w; w.x = cvt_pk_bf16(a0[0], a0[1]); w.y = cvt_pk_bf16(a0[2], a0[3]); w.z = cvt_pk_bf16(a1[0], a1[1]); w.w = cvt_pk_bf16(a1[2], a1[3]);
                    store_rows32(dst + (size_t)(rowt + ai * HALF + m * 16) * (PP * 2), (size_t)PP * 2, fr, fq, w, ost, lane); }
        } else if (t >= 12) {
            unsigned char* dst = (unsigned char*)P + (t < 16 ? PC_GC * 2 + 256 * (t - 12) : PC_GA * 2 + 256 * (t - 16)) + wc * 64;
#pragma unroll
            for (int ai = 0; ai < 2; ++ai)
#pragma unroll
                for (int m = 0; m < 4; ++m) { const f32x4 c0 = ACC(ai, 0, m, 0), c1 = ACC(ai, 0, m, 1), a0 = ACC(ai, 1, m, 0), a1 = ACC(ai, 1, m, 1);
                    *(PG8_LAS v2u*)(ost + fr * 64 + (((8 * fq) >> 4 ^ ((fr >> 1) & 3)) << 4) + ((8 * fq) & 15)) = (v2u){pk4_fp8(c0[0], c0[1], c0[2], c0[3]), pk4_fp8(c1[0], c1[1], c1[2], c1[3])};
                    *(PG8_LAS v2u*)(ost + fr * 64 + ((((32 + 8 * fq) >> 4) ^ ((fr >> 1) & 3)) << 4) + ((8 * fq) & 15)) = (v2u){pk4_fp8(a0[0], a0[1], a0[2], a0[3]), pk4_fp8(a1[0], a1[1], a1[2], a1[3])};
                    asm volatile("s_waitcnt lgkmcnt(0)" ::: "memory");
                    const int r = lane >> 2, c = lane & 3;
                    const u32x4 a = *(const PG8_LAS u32x4*)(ost + r * 64 + ((c ^ ((r >> 1) & 3)) << 4));
                    asm volatile("s_waitcnt lgkmcnt(0)" ::: "memory");
                    *(u32x4*)(dst + (size_t)(rowt + ai * HALF + m * 16 + r) * (PP * 2) + 16 * c) = a; }
        } else if (t >= 6 && t < 10) {
            const bool isq = t < 8; const int head = 4 * (isq ? t - 6 : t - 8) + wc; const float* nwp = isq ? qw : kw;
            const float sc = isq ? 0.125f * 1.4426950408889634f : 1.0f;
            f32x4 nw[2][2];
#pragma unroll
            for (int bj = 0; bj < 2; ++bj)
#pragma unroll
                for (int n = 0; n < 2; ++n) nw[bj][n] = *(const f32x4*)(nwp + 32 * bj + 8 * fq + 4 * n) * sc;
            const int bq = u.pm / 16, tq = (u.pm % 16) * BM + wr * 64;
            bf16_t* dst = isq ? P + (size_t)rowt * PP + PC_Q + head * 64 : KB + ((size_t)(bq * 8 + head) * 4096 + tq) * 64; const size_t ldd = isq ? (size_t)PP : 64;
#pragma unroll
            for (int ai = 0; ai < 2; ++ai)
#pragma unroll
                for (int m = 0; m < 4; ++m) { float ss = 0.f;
#pragma unroll
                    for (int bj = 0; bj < 2; ++bj)
#pragma unroll
                        for (int n = 0; n < 2; ++n) { const f32x4 v = ACC(ai, bj, m, n); ss += (v[0] * v[0] + v[1] * v[1]) + (v[2] * v[2] + v[3] * v[3]); }
                    { const auto a_ = __builtin_amdgcn_permlane32_swap(__float_as_uint(ss), __float_as_uint(ss), false, false); ss = __uint_as_float(a_[0]) + __uint_as_float(a_[1]);
                      const auto b_ = __builtin_amdgcn_permlane16_swap(__float_as_uint(ss), __float_as_uint(ss), false, false); ss = __uint_as_float(b_[0]) + __uint_as_float(b_[1]); }
                    const float rs = 1.0f / sqrtf(ss * (1.0f / 64.0f) + 1e-6f);
                    u32x4 w[2];
#pragma unroll
                    for (int bj = 0; bj < 2; ++bj) { const f32x4 v0 = ACC(ai, bj, m, 0) * rs * nw[bj][0], v1 = ACC(ai, bj, m, 1) * rs * nw[bj][1];
                        w[bj].x = cvt_pk_bf16(v0[0], v0[1]); w[bj].y = cvt_pk_bf16(v0[2], v0[3]); w[bj].z = cvt_pk_bf16(v1[0], v1[1]); w[bj].w = cvt_pk_bf16(v1[2], v1[3]); }
                    store_rows64(dst + (size_t)(ai * HALF + m * 16) * ldd, ldd, fr, fq, w[0], w[1], ost, lane); }
        } else {
            const int bq = u.pm / 16, tq = (u.pm % 16) * BM + wr * 64;
            bf16_t* dst = t < 6 ? P + (size_t)rowt * PP + PC_B + 256 * (t - 4) + wc * 64 : VB + ((size_t)(bq * 8 + 4 * (t - 10) + wc) * 4096 + tq) * 64; const size_t ldd = t < 6 ? (size_t)PP : 64;
#pragma unroll
            for (int ai = 0; ai < 2; ++ai)
#pragma unroll
                for (int m = 0; m < 4; ++m) { u32x4 w[2];
#pragma unroll
                    for (int bj = 0; bj < 2; ++bj) { const f32x4 v0 = ACC(ai, bj, m, 0), v1 = ACC(ai, bj, m, 1);
                        w[bj].x = cvt_pk_bf16(v0[0], v0[1]); w[bj].y = cvt_pk_bf16(v0[2], v0[3]); w[bj].z = cvt_pk_bf16(v1[0], v1[1]); w[bj].w = cvt_pk_bf16(v1[2], v1[3]); }
                    store_rows64(dst + (size_t)(ai * HALF + m * 16) * ldd, ldd, fr, fq, w[0], w[1], ost, lane); }
        }
#undef ACC
    }
};
struct EpiMerge {
    static constexpr bool PERM = true, HAS_MID = true, HAS_SEG = false; static constexpr bool HAS_PRE = false; static constexpr int NVM = 0;
    const bf16_t* P; unsigned char* T; signed char* EX; PG8_LAS unsigned char* ost; PG8_LAS unsigned char* rowmax;
    typedef float f32x2m __attribute__((ext_vector_type(2)));
    static __device__ __forceinline__ void dec8(const v2u w, float (&o)[8]) {
        const f32x2m a = __builtin_amdgcn_cvt_pk_f32_fp8((int)w.x, false), b = __builtin_amdgcn_cvt_pk_f32_fp8((int)w.x, true), c = __builtin_amdgcn_cvt_pk_f32_fp8((int)w.y, false), d = __builtin_amdgcn_cvt_pk_f32_fp8((int)w.y, true);
        o[0] = a.x; o[1] = a.y; o[2] = b.x; o[3] = b.y; o[4] = c.x; o[5] = c.y; o[6] = d.x; o[7] = d.y; }
    __device__ __forceinline__ void gate_to_lds(PG8_LAS unsigned char* blk, u32x4 v, int lane) const { const int r = lane >> 2, c = lane & 3; *(PG8_LAS u32x4*)(blk + r * 64 + ((c ^ ((r >> 1) & 3)) << 4)) = v; }
    __device__ __forceinline__ v2u gate_from_lds(const PG8_LAS unsigned char* blk, int fr, int byte0) const { return *(const PG8_LAS v2u*)(blk + fr * 64 + (((byte0 >> 4) ^ ((fr >> 1) & 3)) << 4) + (byte0 & 15)); }
    __device__ __forceinline__ void mid(f32x4 (&acc)[2][2][4][2], const Unit& u, int wr, int wc, int fr, int fq) const {
        const int lane = fq * 16 + fr, r = lane >> 2, c = lane & 3; PG8_LAS unsigned char* blk = ost + (wr * 4 + wc) * 2048;
        const unsigned char* gp = (const unsigned char*)(P + (size_t)(u.pm * BM + wr * 64 + r) * PP) + u.pn * BM + wc * 64 + 16 * c;
        u32x4 gc[2][4], ga[2][4];
#pragma unroll
        for (int ai = 0; ai < 2; ++ai)
#pragma unroll
            for (int m = 0; m < 4; ++m) { const unsigned char* rp = gp + (size_t)(ai * HALF + m * 16) * (PP * 2); gc[ai][m] = *(const u32x4*)(rp + PC_GC * 2); ga[ai][m] = *(const u32x4*)(rp + PC_GA * 2); }
#pragma unroll
        for (int ai = 0; ai < 2; ++ai)
#pragma unroll
            for (int m = 0; m < 4; ++m) { gate_to_lds(blk, gc[ai][m], lane); gate_to_lds(blk + 1024, ga[ai][m], lane);
                asm volatile("s_waitcnt lgkmcnt(0)" ::: "memory");
                v2u c2[2], a2[2];
#pragma unroll
                for (int bj = 0; bj < 2; ++bj) { c2[bj] = gate_from_lds(blk, fr, 32 * bj + 8 * fq); a2[bj] = gate_from_lds(blk + 1024, fr, 32 * bj + 8 * fq); }
                asm volatile("s_waitcnt lgkmcnt(0)" ::: "memory");
#pragma unroll
                for (int bj = 0; bj < 2; ++bj) { float cc[8], aa[8]; dec8(c2[bj], cc); dec8(a2[bj], aa);
#pragma unroll
                    for (int i = 0; i < 8; ++i) { const float ec = __builtin_amdgcn_exp2f(cc[i]), ea = __builtin_amdgcn_exp2f(aa[i]);
                        acc[ai][bj][m][i >> 2][i & 3] *= (1.0f + ea) * __builtin_amdgcn_rcpf(1.0f + ec); } } }
    }
    __device__ __forceinline__ void operator()(f32x4 (&acc)[2][2][4][2], const Unit& u, int wr, int wc, int fr, int fq) const {
        const int rowt = u.pm * BM + wr * 64, colw = u.pn * BM + wc * 64; const int lane = fq * 16 + fr, r = lane >> 2, c = lane & 3; PG8_LAS unsigned char* blk = ost + (wr * 4 + wc) * 2048;
        const unsigned char* gp = (const unsigned char*)(P + (size_t)(rowt + r) * PP) + colw + 16 * c + PC_GA * 2;
        u32x4 gaa[2][4];
#pragma unroll
        for (int ai = 0; ai < 2; ++ai)
#pragma unroll
            for (int m = 0; m < 4; ++m) gaa[ai][m] = *(const u32x4*)(gp + (size_t)(ai * HALF + m * 16) * (PP * 2));
        PG8_LAS float* rmx = (PG8_LAS float*)(rowmax);
#pragma unroll
        for (int ai = 0; ai < 2; ++ai)
#pragma unroll
            for (int m = 0; m < 4; ++m) {
                gate_to_lds(blk + 1024, gaa[ai][m], lane);
                asm volatile("s_waitcnt lgkmcnt(0)" ::: "memory");
                v2u a2[2];
#pragma unroll
                for (int bj = 0; bj < 2; ++bj) a2[bj] = gate_from_lds(blk + 1024, fr, 32 * bj + 8 * fq);
                asm volatile("s_waitcnt lgkmcnt(0)" ::: "memory");
                float mx = 0.f;
#pragma unroll
                for (int bj = 0; bj < 2; ++bj) { float a[8]; dec8(a2[bj], a);
#pragma unroll
                    for (int i = 0; i < 8; ++i) { const float v = acc[ai][bj][m][i >> 2][i & 3] * __builtin_amdgcn_rcpf(1.0f + __builtin_amdgcn_exp2f(a[i])); acc[ai][bj][m][i >> 2][i & 3] = v; mx = fmaxf(mx, fabsf(v)); } }
                { const auto p_ = __builtin_amdgcn_permlane32_swap(__float_as_uint(mx), __float_as_uint(mx), false, false); mx = fmaxf(__uint_as_float(p_[0]), __uint_as_float(p_[1]));
                  const auto q_ = __builtin_amdgcn_permlane16_swap(__float_as_uint(mx), __float_as_uint(mx), false, false); mx = fmaxf(__uint_as_float(q_[0]), __uint_as_float(q_[1])); }
                if (fq == 0) rmx[(ai * HALF + wr * 64 + m * 16 + fr) * 4 + wc] = mx; }
        asm volatile("s_waitcnt lgkmcnt(0)" ::: "memory"); __builtin_amdgcn_s_barrier(); asm volatile("" ::: "memory");
#pragma unroll
        for (int ai = 0; ai < 2; ++ai)
#pragma unroll
            for (int m = 0; m < 4; ++m) { const int rl = ai * HALF + wr * 64 + m * 16 + fr;
                const f32x4 q4 = *(const PG8_LAS f32x4*)(rmx + rl * 4); const float mx = fmaxf(fmaxf(q4[0], q4[1]), fmaxf(q4[2], q4[3]));
                int ex; const float fm = __builtin_frexpf(mx, &ex);
                const int e = mx > 0.f ? (fm <= 0.9921875f ? ex - 7 : ex - 6) : 0;
                const float inv = __builtin_ldexpf(1.0f, -e);
                v2u w[2];
#pragma unroll
                for (int bj = 0; bj < 2; ++bj) { const f32x4 v0 = acc[ai][bj][m][0] * inv, v1 = acc[ai][bj][m][1] * inv; w[bj].x = pk4_i8(v0[0], v0[1], v0[2], v0[3]); w[bj].y = pk4_i8(v1[0], v1[1], v1[2], v1[3]); }
                store_rows32_2x8(T + (size_t)(rowt + ai * HALF + m * 16) * 1024 + colw, 1024, fr, fq, w[0], w[1], blk, lane);
                if (wc == 0 && fq == 0) EX[(size_t)(u.pm * BM + rl) * 4 + u.pn] = (signed char)(e - MRG_EXP); }
    }
};

struct EpiNull {
    static constexpr bool PERM = true, HAS_MID = false, HAS_SEG = false; static constexpr bool HAS_PRE = false; static constexpr int NVM = 0;
    __device__ __forceinline__ void operator()(const f32x4 (&acc)[2][2][4][2], const Unit&, int, int, int, int) const {
#pragma unroll
        for (int a = 0; a < 2; ++a)
#pragma unroll
            for (int b = 0; b < 2; ++b)
#pragma unroll
                for (int m = 0; m < 4; ++m)
#pragma unroll
                    for (int n = 0; n < 2; ++n) asm volatile("" :: "v"(acc[a][b][m][n]));
    }
};

struct EpiDelta {
    static constexpr bool PERM = true, HAS_MID = false, HAS_SEG = false; static constexpr bool HAS_PRE = false; static constexpr int NVM = 0;
    const float* mod; const float* X; bf16_t* T; float ascale; PG8_LAS unsigned char* ost0;
    __device__ __forceinline__ void operator()(const f32x4 (&acc)[2][2][4][2], const Unit& u, int wr, int wc, int fr, int fq) const {
        const int rowt = u.pm * BM + wr * 64, colw = u.pn * BM + wc * 64; PG8_LAS unsigned char* ost = ost0 + (wr * 4 + wc) * 2048;
        const int lane = fq * 16 + fr, r = lane >> 3, c = lane & 7;
        const float* gate = mod + (size_t)(u.pm / 16) * 6144 + 2048;
        f32x4 gv[2][2];
#pragma unroll
        for (int bj = 0; bj < 2; ++bj)
#pragma unroll
            for (int n = 0; n < 2; ++n) gv[bj][n] = *(const f32x4*)(gate + colw + 32 * bj + 8 * fq + 4 * n) * ascale;
#pragma unroll
        for (int ai = 0; ai < 2; ++ai) { f32x4 xs[4][2][2];
#pragma unroll
            for (int m = 0; m < 4; ++m)
#pragma unroll
                for (int h = 0; h < 2; ++h) { const float* xp = X + (size_t)(rowt + ai * HALF + m * 16 + r + 8 * h) * 1024 + colw + 8 * c; xs[m][h][0] = *(const f32x4*)xp; xs[m][h][1] = *(const f32x4*)(xp + 4); }
#pragma unroll
            for (int m = 0; m < 4; ++m) { u32x4 w[2];
#pragma unroll
                for (int bj = 0; bj < 2; ++bj) { const f32x4 v0 = acc[ai][bj][m][0] * gv[bj][0], v1 = acc[ai][bj][m][1] * gv[bj][1];
                    w[bj].x = cvt_pk_bf16(v0[0], v0[1]); w[bj].y = cvt_pk_bf16(v0[2], v0[3]); w[bj].z = cvt_pk_bf16(v1[0], v1[1]); w[bj].w = cvt_pk_bf16(v1[2], v1[3]); }
                *(PG8_LAS u32x4*)(ost + fr * 128 + ((fq ^ (fr & 7)) << 4)) = w[0]; *(PG8_LAS u32x4*)(ost + fr * 128 + (((fq + 4) ^ (fr & 7)) << 4)) = w[1];
                asm volatile("s_waitcnt lgkmcnt(0)" ::: "memory");
                const u32x4 a = *(const PG8_LAS u32x4*)(ost + r * 128 + ((c ^ (r & 7)) << 4)), b = *(const PG8_LAS u32x4*)(ost + (r + 8) * 128 + ((c ^ (r & 7)) << 4));
                asm volatile("s_waitcnt lgkmcnt(0)" ::: "memory");
                bf16_t* tp = T + (size_t)(rowt + ai * HALF + m * 16 + r) * 1024 + colw + 8 * c;
                { const f32x4 x0 = xs[m][0][0], x1 = xs[m][0][1]; u32x4 o; o.x = cvt_pk_bf16(x0[0] + bf_lo(a.x), x0[1] + bf_hi(a.x)); o.y = cvt_pk_bf16(x0[2] + bf_lo(a.y), x0[3] + bf_hi(a.y)); o.z = cvt_pk_bf16(x1[0] + bf_lo(a.z), x1[1] + bf_hi(a.z)); o.w = cvt_pk_bf16(x1[2] + bf_lo(a.w), x1[3] + bf_hi(a.w)); *(u32x4*)tp = o; }
                { const f32x4 x0 = xs[m][1][0], x1 = xs[m][1][1]; u32x4 o; o.x = cvt_pk_bf16(x0[0] + bf_lo(b.x), x0[1] + bf_hi(b.x)); o.y = cvt_pk_bf16(x0[2] + bf_lo(b.y), x0[3] + bf_hi(b.y)); o.z = cvt_pk_bf16(x1[0] + bf_lo(b.z), x1[1] + bf_hi(b.z)); o.w = cvt_pk_bf16(x1[2] + bf_lo(b.w), x1[3] + bf_hi(b.w)); *(u32x4*)(tp + 8 * 1024) = o; } }
            asm volatile("" ::: "memory"); }
    }
};
struct EpiDelta8 {
    static constexpr bool PERM = true, HAS_MID = false, HAS_SEG = true; static constexpr bool HAS_PRE = false; static constexpr int NVM = 0;
    const float* mod; const float* X; bf16_t* T; const signed char* EX; const float* cs; PG8_LAS unsigned char* ost0;
    __device__ __forceinline__ void seg_fetch(const Unit& u, int wr, int wc, int fr, int fq) const {
        const unsigned ldsb = (unsigned)(__SIZE_TYPE__)(ost0 + (wr * 4 + wc) * 2048);
#pragma unroll
        for (int j = 0; j < 8; ++j) glds4_s(EX, (unsigned)(u.pm * BM + wr * 64 + fr + (j >> 2) * HALF + (j & 3) * 16) * 4u, ldsb + 256u * j);
    }
    __device__ __forceinline__ void seg(f32x4 (&acc)[2][2][4][2], const Unit& u, int sg, int wr, int wc, int fr, int fq) const {
        PG8_LAS unsigned char* blk = ost0 + (wr * 4 + wc) * 2048; const int lane = fq * 16 + fr;
#pragma unroll
        for (int ai = 0; ai < 2; ++ai)
#pragma unroll
            for (int m = 0; m < 4; ++m) { const unsigned wd = *(const PG8_LAS unsigned*)(blk + 256 * (ai * 4 + m) + 4 * lane);
                const int ec = (int)(signed char)((wd >> (8 * sg)) & 0xffu), ep = (int)(signed char)((wd >> (8 * sg - 8)) & 0xffu); const int d = ec - ep;
                const int sr = d > 0 ? d : 0, sl = d < 0 ? -d : 0;
#pragma unroll
                for (int bj = 0; bj < 2; ++bj)
#pragma unroll
                    for (int n = 0; n < 2; ++n) { v4i_t a = __builtin_bit_cast(v4i_t, acc[ai][bj][m][n]); a = (a >> sr) << sl; acc[ai][bj][m][n] = __builtin_bit_cast(f32x4, a); } }
    }
    __device__ __forceinline__ void operator()(const f32x4 (&acc)[2][2][4][2], const Unit& u, int wr, int wc, int fr, int fq) const {
        const int rowt = u.pm * BM + wr * 64, colw = u.pn * BM + wc * 64; PG8_LAS unsigned char* ost = ost0 + (wr * 4 + wc) * 2048;
        const int lane = fq * 16 + fr, r = lane >> 3, c = lane & 7;
        unsigned st[8];
#pragma unroll
        for (int j = 0; j < 8; ++j) st[j] = *(const PG8_LAS unsigned*)(ost + 256 * j + 4 * lane);
        asm volatile("s_waitcnt lgkmcnt(0)" ::: "memory");
        const float* gate = mod + (size_t)(u.pm / 16) * 6144 + 2048;
        f32x4 gv[2][2];
#pragma unroll
        for (int bj = 0; bj < 2; ++bj)
#pragma unroll
            for (int n = 0; n < 2; ++n) gv[bj][n] = *(const f32x4*)(gate + colw + 32 * bj + 8 * fq + 4 * n) * *(const f32x4*)(cs + u.pn * BM + bj * HALF + wc * 32 + 8 * fq + 4 * n);
#pragma unroll
        for (int ai = 0; ai < 2; ++ai) { f32x4 xs[4][2][2];
#pragma unroll
            for (int m = 0; m < 4; ++m)
#pragma unroll
                for (int h = 0; h < 2; ++h) { const float* xp = X + (size_t)(rowt + ai * HALF + m * 16 + r + 8 * h) * 1024 + colw + 8 * c; xs[m][h][0] = *(const f32x4*)xp; xs[m][h][1] = *(const f32x4*)(xp + 4); }
#pragma unroll
            for (int m = 0; m < 4; ++m) { u32x4 w[2];
                const float rsc = __builtin_ldexpf(1.0f, (int)(signed char)(st[ai * 4 + m] >> 24));
#pragma unroll
                for (int bj = 0; bj < 2; ++bj) { const f32x4 v0 = __builtin_convertvector(__builtin_bit_cast(v4i_t, acc[ai][bj][m][0]), f32x4) * (gv[bj][0] * rsc), v1 = __builtin_convertvector(__builtin_bit_cast(v4i_t, acc[ai][bj][m][1]), f32x4) * (gv[bj][1] * rsc);
                    w[bj].x = cvt_pk_bf16(v0[0], v0[1]); w[bj].y = cvt_pk_bf16(v0[2], v0[3]); w[bj].z = cvt_pk_bf16(v1[0], v1[1]); w[bj].w = cvt_pk_bf16(v1[2], v1[3]); }
                *(PG8_LAS u32x4*)(ost + fr * 128 + ((fq ^ (fr & 7)) << 4)) = w[0]; *(PG8_LAS u32x4*)(ost + fr * 128 + (((fq + 4) ^ (fr & 7)) << 4)) = w[1];
                asm volatile("s_waitcnt lgkmcnt(0)" ::: "memory");
                const u32x4 a = *(const PG8_LAS u32x4*)(ost + r * 128 + ((c ^ (r & 7)) << 4)), b = *(const PG8_LAS u32x4*)(ost + (r + 8) * 128 + ((c ^ (r & 7)) << 4));
                asm volatile("s_waitcnt lgkmcnt(0)" ::: "memory");
                bf16_t* tp = T + (size_t)(rowt + ai * HALF + m * 16 + r) * 1024 + colw + 8 * c;
                { const f32x4 x0 = xs[m][0][0], x1 = xs[m][0][1]; u32x4 o; o.x = cvt_pk_bf16(x0[0] + bf_lo(a.x), x0[1] + bf_hi(a.x)); o.y = cvt_pk_bf16(x0[2] + bf_lo(a.y), x0[3] + bf_hi(a.y)); o.z = cvt_pk_bf16(x1[0] + bf_lo(a.z), x1[1] + bf_hi(a.z)); o.w = cvt_pk_bf16(x1[2] + bf_lo(a.w), x1[3] + bf_hi(a.w)); *(u32x4*)tp = o; }
                { const f32x4 x0 = xs[m][1][0], x1 = xs[m][1][1]; u32x4 o; o.x = cvt_pk_bf16(x0[0] + bf_lo(b.x), x0[1] + bf_hi(b.x)); o.y = cvt_pk_bf16(x0[2] + bf_lo(b.y), x0[3] + bf_hi(b.y)); o.z = cvt_pk_bf16(x1[0] + bf_lo(b.z), x1[1] + bf_hi(b.z)); o.w = cvt_pk_bf16(x1[2] + bf_lo(b.w), x1[3] + bf_hi(b.w)); *(u32x4*)(tp + 8 * 1024) = o; } }
            asm volatile("" ::: "memory"); }
    }
};
struct EpiResid {
    static constexpr bool PERM = false, HAS_MID = false, HAS_SEG = false; static constexpr bool HAS_PRE = false; static constexpr int NVM = 0;
    const float* X; const float* mod; float* out; int ldc;
    __device__ __forceinline__ void operator()(const f32x4 (&acc)[2][2][4][2], const Unit& u, int wr, int wc, int fr, int fq) const {
        const int row0 = u.pm * BM + wr * 64 + fr, col0 = u.pn * BM + wc * 32 + 4 * fq;
        const float* gate = mod + (size_t)(u.pm / 16) * 6144 + 2048;
        f32x4 gv[2][2];
#pragma unroll
        for (int bj = 0; bj < 2; ++bj)
#pragma unroll
            for (int n = 0; n < 2; ++n) gv[bj][n] = *(const f32x4*)(gate + col0 + bj * HALF + n * 16);
#pragma unroll
        for (int ai = 0; ai < 2; ++ai) { f32x4 xs[4][2][2];
#pragma unroll
            for (int m = 0; m < 4; ++m) { const size_t off = (size_t)(row0 + ai * HALF + m * 16) * ldc + col0;
#pragma unroll
                for (int bj = 0; bj < 2; ++bj)
#pragma unroll
                    for (int n = 0; n < 2; ++n) xs[m][bj][n] = *(const f32x4*)(X + off + bj * HALF + n * 16); }
#pragma unroll
            for (int m = 0; m < 4; ++m) { const size_t off = (size_t)(row0 + ai * HALF + m * 16) * ldc + col0;
#pragma unroll
                for (int bj = 0; bj < 2; ++bj)
#pragma unroll
                    for (int n = 0; n < 2; ++n) *(f32x4*)(out + off + bj * HALF + n * 16) = xs[m][bj][n] + gv[bj][n] * acc[ai][bj][m][n]; }
            asm volatile("" ::: "memory"); }
    }
};
struct EpiLogits {
    static constexpr bool PERM = false, HAS_MID = false, HAS_SEG = false; static constexpr bool HAS_PRE = false; static constexpr int NVM = 0;
    float* L; int ldl, ncols; const PG8_LAS float* rs2;
    __device__ __forceinline__ void operator()(const f32x4 (&acc)[2][2][4][2], const Unit& u, int wr, int wc, int fr, int fq) const {
        const int row0 = u.pm * BM + wr * 64 + fr;
#pragma unroll
        for (int n = 0; n < 2; ++n) { const int c = wc * 32 + n * 16 + 4 * fq;
            if (c < ncols) {
#pragma unroll
                for (int ai = 0; ai < 2; ++ai)
#pragma unroll
                    for (int m = 0; m < 4; ++m) *(f32x4*)(L + (size_t)(row0 + ai * HALF + m * 16) * ldl + c) = acc[ai][0][m][n] * rs2[wr * 64 + fr + ai * HALF + m * 16]; } }
    }
};
struct EpiGLU {
    static constexpr bool PERM = true, HAS_MID = false, HAS_SEG = false; static constexpr bool HAS_PRE = false; static constexpr int NVM = 0;
    unsigned char* ACT; const float* WL; float ascale; PG8_LAS unsigned char* ost0;
    __device__ __forceinline__ void operator()(const f32x4 (&acc)[2][2][4][2], const Unit& u, int wr, int wc, int fr, int fq) const {
        const int rl0 = wr * 64 + fr;
        unsigned char* dst = ACT + (size_t)(u.pm * BM + wr * 64) * 256 + u.pn * HALF + wc * 32;
#pragma unroll
        for (int ai = 0; ai < 2; ++ai)
#pragma unroll
            for (int m = 0; m < 4; ++m) { const int rl = rl0 + ai * HALF + m * 16; const int p = u.lt * BM + rl;
                int pi = p < 65536 ? p : 65535; asm volatile("" : "+v"(pi));
                const float wv = WL[(size_t)u.e * 65536 + pi]; const float w = p < u.cnt ? wv * A8_SCALE : 0.f;
                const f32x4 g0 = acc[ai][0][m][0] * ascale, g1 = acc[ai][0][m][1] * ascale, u0 = acc[ai][1][m][0] * ascale, u1 = acc[ai][1][m][1] * ascale;
                float o[8];
#pragma unroll
                for (int i = 0; i < 4; ++i) { o[i] = g0[i] * sigmoid_f(g0[i]) * u0[i] * w; o[4 + i] = g1[i] * sigmoid_f(g1[i]) * u1[i] * w; }
                int ro = (ai * HALF + m * 16 + fr) * 256 + 8 * fq; asm volatile("" : "+v"(ro));
                *(v2u*)(dst + ro) = (v2u){pk4_fp8(o[0], o[1], o[2], o[3]), pk4_fp8(o[4], o[5], o[6], o[7])};
                asm volatile("" ::: "memory"); }
    }
};
template <int SUB, size_t a_tstep, size_t b_estep, size_t b_tstep> struct MoeSched {
    const char* A; const char* Bt; const int* list; const PG8_LAS int* tab; int G, c;
    __device__ __forceinline__ bool next(int i, Unit& u) const {
        int z_ = 0; asm volatile("" : "+v"(z_)); const PG8_LAS int* tab = this->tab + z_;
        const int L = i * G + c, T = L / SUB; const int ttot = __builtin_amdgcn_readfirstlane(tab[32]);
        if (T >= ttot) return false;
        const int e = __builtin_amdgcn_readfirstlane(tab[256 + T]);
        u.pm = __builtin_amdgcn_readfirstlane(T); u.pn = __builtin_amdgcn_readfirstlane(L % SUB); u.e = __builtin_amdgcn_readfirstlane(e); u.lt = T - __builtin_amdgcn_readfirstlane(tab[e]); u.cnt = __builtin_amdgcn_readfirstlane(tab[64 + e]); return true;
    }
    __device__ __forceinline__ const char* a_base(const Unit& u) const { return A + (size_t)u.pm * a_tstep; }
    __device__ __forceinline__ const char* b_base(const Unit& u) const { return Bt + (size_t)u.e * b_estep + (size_t)u.pn * b_tstep; }
    __device__ __forceinline__ void ids_dma(const Unit& u, int r, unsigned lds_dst) const { const int p = u.lt * BM + r; glds4_s(list, ((unsigned)u.e * 65536u + (unsigned)(p < 65536 ? p : 65535)) * 4u, lds_dst); }
    __device__ __forceinline__ int row_pick(const Unit& u, int r, int v) const { return u.lt * BM + r < u.cnt ? v : 0; }
    __device__ __forceinline__ int row_index(const Unit& u, int r) const { const int p = u.lt * BM + r; const int v = list[(size_t)u.e * 65536 + (p < 65536 ? p : 65535)]; return p < u.cnt ? v : 0; }
};
}
struct Frame {
    LAS unsigned char* lds;
    volatile LAS unsigned* MISC;
    gu32* ctl;
    int wave;
    int vcu, G;
    const LAS unsigned long long* ptab;
    float* out; unsigned char* ws;
};
__device__ __forceinline__ const float* inp(const Frame& F, int k) { const unsigned long long v = F.ptab[k]; const unsigned lo = __builtin_amdgcn_readfirstlane((unsigned)v), hi = __builtin_amdgcn_readfirstlane((unsigned)(v >> 32)); return (const float*)(const GAS float*)(((unsigned long long)hi << 32) | lo); }
__device__ __forceinline__ float wave_sum(float v) {
    { const auto a = __builtin_amdgcn_permlane32_swap(__float_as_uint(v), __float_as_uint(v), false, false); v = __uint_as_float(a[0]) + __uint_as_float(a[1]); }
    { const auto a = __builtin_amdgcn_permlane16_swap(__float_as_uint(v), __float_as_uint(v), false, false); v = __uint_as_float(a[0]) + __uint_as_float(a[1]); }
    v += __uint_as_float((unsigned)__builtin_amdgcn_update_dpp(0, (int)__float_as_uint(v), 0x128, 0xf, 0xf, false));
    v += __uint_as_float((unsigned)__builtin_amdgcn_update_dpp(0, (int)__float_as_uint(v), 0x124, 0xf, 0xf, false));
    v += __uint_as_float((unsigned)__builtin_amdgcn_update_dpp(0, (int)__float_as_uint(v), 0x122, 0xf, 0xf, false));
    v += __uint_as_float((unsigned)__builtin_amdgcn_update_dpp(0, (int)__float_as_uint(v), 0x121, 0xf, 0xf, false));
    return v;
}
__device__ __forceinline__ float wave_max(float v) {
    { const auto a = __builtin_amdgcn_permlane32_swap(__float_as_uint(v), __float_as_uint(v), false, false); v = fmaxf(__uint_as_float(a[0]), __uint_as_float(a[1])); }
    { const auto a = __builtin_amdgcn_permlane16_swap(__float_as_uint(v), __float_as_uint(v), false, false); v = fmaxf(__uint_as_float(a[0]), __uint_as_float(a[1])); }
    v = fmaxf(v, __uint_as_float((unsigned)__builtin_amdgcn_update_dpp(0, (int)__float_as_uint(v), 0x128, 0xf, 0xf, false)));
    v = fmaxf(v, __uint_as_float((unsigned)__builtin_amdgcn_update_dpp(0, (int)__float_as_uint(v), 0x124, 0xf, 0xf, false)));
    v = fmaxf(v, __uint_as_float((unsigned)__builtin_amdgcn_update_dpp(0, (int)__float_as_uint(v), 0x122, 0xf, 0xf, false)));
    v = fmaxf(v, __uint_as_float((unsigned)__builtin_amdgcn_update_dpp(0, (int)__float_as_uint(v), 0x121, 0xf, 0xf, false)));
    return v;
}
__device__ __forceinline__ void cmax_item(const float* src, int ldw, unsigned* cmax, int lane) {
    f32x4 m = {0.f, 0.f, 0.f, 0.f};
#pragma unroll
    for (int i = 0; i < 8; ++i) { const f32x4 t = *(const f32x4*)(src + (size_t)(8 * i + (lane >> 3)) * ldw + 4 * (lane & 7)); m.x = fmaxf(m.x, fabsf(t.x)); m.y = fmaxf(m.y, fabsf(t.y)); m.z = fmaxf(m.z, fabsf(t.z)); m.w = fmaxf(m.w, fabsf(t.w)); }
#pragma unroll
    for (int o = 8; o < 64; o <<= 1) { m.x = fmaxf(m.x, __shfl_xor(m.x, o)); m.y = fmaxf(m.y, __shfl_xor(m.y, o)); m.z = fmaxf(m.z, __shfl_xor(m.z, o)); m.w = fmaxf(m.w, __shfl_xor(m.w, o)); }
    if (lane < 8) { unsigned* c = cmax + 4 * lane;
        __hip_atomic_fetch_max(c + 0, __float_as_uint(m.x), __ATOMIC_RELAXED, __HIP_MEMORY_SCOPE_AGENT); __hip_atomic_fetch_max(c + 1, __float_as_uint(m.y), __ATOMIC_RELAXED, __HIP_MEMORY_SCOPE_AGENT);
        __hip_atomic_fetch_max(c + 2, __float_as_uint(m.z), __ATOMIC_RELAXED, __HIP_MEMORY_SCOPE_AGENT); __hip_atomic_fetch_max(c + 3, __float_as_uint(m.w), __ATOMIC_RELAXED, __HIP_MEMORY_SCOPE_AGENT); }
}
__device__ __forceinline__ void tr_item_q8(const float* src, int ldw, unsigned char* dst, int ldd, const unsigned* cmax, float* cs, LAS float* scr, int lane) {
    { f32x4 t[8];
#pragma unroll
      for (int i = 0; i < 8; ++i) t[i] = *(const f32x4*)(src + (size_t)(8 * i + (lane >> 3)) * ldw + 4 * (lane & 7));
#pragma unroll
      for (int i = 0; i < 8; ++i) { LAS float* d = scr + (8 * i + (lane >> 3)) * 33 + 4 * (lane & 7); d[0] = t[i].x; d[1] = t[i].y; d[2] = t[i].z; d[3] = t[i].w; } }
    LDS_WAIT(); asm volatile("" ::: "memory");
    const int c = lane & 7;
#pragma unroll
    for (int j = 0; j < 4; ++j) { const int n = (lane >> 3) + 8 * j; const LAS float* s = scr + (8 * c) * 33 + n;
        const float mx = __uint_as_float(__hip_atomic_load(cmax + n, __ATOMIC_RELAXED, __HIP_MEMORY_SCOPE_AGENT)); const float inv = mx > 0.f ? 127.0f / mx : 0.f;
        v2u o; o.x = pk4_i8(s[0 * 33] * inv, s[1 * 33] * inv, s[2 * 33] * inv, s[3 * 33] * inv); o.y = pk4_i8(s[4 * 33] * inv, s[5 * 33] * inv, s[6 * 33] * inv, s[7 * 33] * inv);
        *(GAS v2u*)(dst + (size_t)n * ldd + 8 * c) = o;
        if (cs && c == 0) cs[n] = mx * (1.0f / 127.0f); }
    LDS_WAIT(); asm volatile("" ::: "memory");
}
__device__ __forceinline__ void tr_item(const float* src, int ldw, bf16* dst, int ldd, LAS float* scr, int lane) {
    { f32x4 t[8];
#pragma unroll
      for (int i = 0; i < 8; ++i) t[i] = *(const f32x4*)(src + (size_t)(8 * i + (lane >> 3)) * ldw + 4 * (lane & 7));
#pragma unroll
      for (int i = 0; i < 8; ++i) { LAS float* d = scr + (8 * i + (lane >> 3)) * 33 + 4 * (lane & 7); d[0] = t[i].x; d[1] = t[i].y; d[2] = t[i].z; d[3] = t[i].w; } }
    LDS_WAIT(); asm volatile("" ::: "memory");
    const int c = lane & 7;
#pragma unroll
    for (int j = 0; j < 4; ++j) { const int n = (lane >> 3) + 8 * j; const LAS float* s = scr + (8 * c) * 33 + n;
        v4u o; o.x = pk2(s[0 * 33], s[1 * 33]); o.y = pk2(s[2 * 33], s[3 * 33]); o.z = pk2(s[4 * 33], s[5 * 33]); o.w = pk2(s[6 * 33], s[7 * 33]);
        *(GAS v4u*)(dst + (size_t)n * ldd + 8 * c) = o; }
    LDS_WAIT(); asm volatile("" ::: "memory");
}

__device__ __forceinline__ void tr_item8(const float* src, int ldw, unsigned char* dst, int ldd, float scale, LAS float* scr, int lane) {
    { f32x4 t[8];
#pragma unroll
      for (int i = 0; i < 8; ++i) t[i] = *(const f32x4*)(src + (size_t)(8 * i + (lane >> 3)) * ldw + 4 * (lane & 7));
#pragma unroll
      for (int i = 0; i < 8; ++i) { LAS float* d = scr + (8 * i + (lane >> 3)) * 33 + 4 * (lane & 7); d[0] = t[i].x; d[1] = t[i].y; d[2] = t[i].z; d[3] = t[i].w; } }
    LDS_WAIT(); asm volatile("" ::: "memory");
    const int c = lane & 7;
#pragma unroll
    for (int j = 0; j < 4; ++j) { const int n = (lane >> 3) + 8 * j; const LAS float* s = scr + (8 * c) * 33 + n;
        v2u o; o.x = pk4_fp8(s[0 * 33] * scale, s[1 * 33] * scale, s[2 * 33] * scale, s[3 * 33] * scale); o.y = pk4_fp8(s[4 * 33] * scale, s[5 * 33] * scale, s[6 * 33] * scale, s[7 * 33] * scale);
        *(GAS v2u*)(dst + (size_t)n * ldd + 8 * c) = o; }
    LDS_WAIT(); asm volatile("" ::: "memory");
}
#define COL64ROW(n0) ((((n0) >> 8) << 8) + 128 * ((((n0) & 255) >> 5) & 1) + 32 * (((n0) & 255) >> 6))
__device__ __forceinline__ void p0_prologue(Frame& F) {
    const int lane = mk_lane(), tid = F.wave * 64 + lane; (void)tid;
    const float* const in1_ = inp(F, 1);
    const float* const in2_ = inp(F, 2);
    const float* const in5_ = inp(F, 5);
    const float* const in10_ = inp(F, 10);
    const float* const in11_ = inp(F, 11);
    const float* const in12_ = inp(F, 12);
    const float* const in14_ = inp(F, 14);
    const float* const in16_ = inp(F, 16);
    const float* const in18_ = inp(F, 18);
    const float* const in19_ = inp(F, 19);
    const float* const in20_ = inp(F, 20);
    LAS float* scr = (LAS float*)(F.lds + RING_OFF + F.wave * 16384);
    const int gw = F.vcu * NWAVES + F.wave, NGW = F.G * NWAVES;
    unsigned char* WOC = (unsigned char*)(F.ws + WS_WOC);
    constexpr int I_IN = 16 * 160, I_OC = 8 * 32, I_O = 16 * 32, I_G = 32 * 128, I_D = 32 * 128;
    constexpr int NITEMS = I_IN + 2 * I_OC + I_O;
    static_assert(N_LAUNCHES == 1, "the deferred weight copies ride on the one-launch phase program");
    for (int it = gw; it < NITEMS; it += NGW) {
        int r = it;
        if (r < I_IN) { const int kb = r / 160, nb = r % 160, n0 = 32 * nb, t = n0 >> 8, rho = n0 & 255; int sc;
            const int c64 = 64 * ((rho >> 5) & 3) + 32 * (rho >> 7);
            if (t < 4) sc = rho < 128 ? 128 * t + rho : 1024 + 128 * t + (rho - 128); else if (t < 6) sc = 512 + 256 * (t - 4) + c64;
            else if (t < 10) sc = (t < 8 ? 1536 : 2048) + 256 * (t < 8 ? t - 6 : t - 8) + c64; else if (t < 12) sc = 2560 + 256 * (t - 10) + c64;
            else if (t < 16) sc = 3080 + 256 * (t - 12) + c64; else sc = 4104 + 256 * (t - 16) + c64;
            cmax_item(in5_ + (size_t)(64 * kb) * INC + sc, INC, (unsigned*)(F.ctl + CW_CMAX) + n0, lane);
            continue; } r -= I_IN;
        if (r < I_OC) { const int kb = r / 32, nb = r % 32; tr_item8(in10_ + (size_t)(64 * kb) * 1024 + 32 * nb, 1024, WOC + (size_t)COL64ROW(32 * nb) * 1024 + 64 * kb, 1024, W8_SCALE, scr, lane); continue; } r -= I_OC;
        if (r < I_OC) { const int kb = r / 32, nb = r % 32; tr_item8(in11_ + (size_t)(64 * kb) * 1024 + 32 * nb, 1024, WOC + (size_t)COL64ROW(32 * nb) * 1024 + 512 + 64 * kb, 1024, W8_SCALE, scr, lane); continue; } r -= I_OC;
        if (r < I_O) { const int kb = r / 32, nb = r % 32; cmax_item(in12_ + (size_t)(64 * kb) * 1024 + 32 * nb, 1024, (unsigned*)(F.ctl + CW_CMAX) + PP5 + COL64ROW(32 * nb), lane); continue; } r -= I_O;
    }
    float* MODP = (float*)(F.ws + WS_MODP);
    for (int task = gw; task < 96 * 16; task += NGW) {
        const int cg = task % 96, ks = task / 96, j = cg * 64 + lane, k0 = ks * 64;
#pragma unroll
        for (int b = 0; b < 16; ++b) { const float v = in1_[b * 1024 + k0 + lane]; scr[lane * 16 + b] = v / (1.0f + __expf(-v)); }
        LDS_WAIT(); asm volatile("" ::: "memory");
        float acc[16];
#pragma unroll
        for (int b = 0; b < 16; ++b) acc[b] = 0.f;
#pragma unroll 8
        for (int kk = 0; kk < 64; ++kk) { const float w = in2_[(size_t)(k0 + kk) * MODC + j];
#pragma unroll
            for (int q = 0; q < 4; ++q) { const f32x4 s = *(const LAS f32x4*)(scr + kk * 16 + 4 * q); acc[4 * q] += s.x * w; acc[4 * q + 1] += s.y * w; acc[4 * q + 2] += s.z * w; acc[4 * q + 3] += s.w * w; } }
#pragma unroll
        for (int b = 0; b < 16; ++b) MODP[((size_t)ks * 16 + b) * MODC + j] = acc[b];
        LDS_WAIT(); asm volatile("" ::: "memory");
    }
    const int gt = (F.vcu * NWAVES + F.wave) * 64 + lane, NGT = NGW * 64;
    float* WF = (float*)(F.ws + WS_WF);
    for (int idx = gt; idx < 8 * 1024; idx += NGT) { const int cidx = idx >> 10, k = idx & 1023; WF[idx] = in5_[(size_t)k * INC + 3072 + cidx]; }
}

__device__ __forceinline__ void wgu_item(Frame& F, int r) {
    const int lane = mk_lane();
    LAS float* scr = (LAS float*)(F.lds + RING_OFF + F.wave * 16384);
    const int up = r >= 32 * 128 ? 1 : 0; r -= up * 32 * 128; const int e = r / 128, q = r % 128, kb = q / 8, nb = q % 8, j0 = 32 * nb, row = (j0 / 128) * 256 + up * 128 + (j0 % 128);
    tr_item8((up ? inp(F, 19) : inp(F, 18)) + (size_t)e * 1024 * 256 + (size_t)(64 * kb) * 256 + j0, 256, (unsigned char*)(F.ws + WS_WGU) + ((size_t)e * 512 + row) * 1024 + 64 * kb, 1024, W8_SCALE, scr, lane);
}
__device__ __forceinline__ void p7_wd_items(Frame& F) {
    const int lane = mk_lane();
    const float* const in20_ = inp(F, 20);
    const LAS int* tab = (const LAS int*)(F.lds + TAB_OFF);
    LAS float* scr = (LAS float*)(F.lds + RING_OFF + F.wave * 16384);
    const int total = tab[32] * 2, rounds = (total + F.G - 1) / F.G, rem = total - (rounds - 1) * F.G;
    int rank = F.vcu, n = F.G;
    if (F.G - rem >= 64) { if (F.vcu < rem) return; rank = F.vcu - rem; n = F.G - rem; }
    for (int r = rank * NWAVES + F.wave; r < 32 * 128; r += n * NWAVES) { const int e = r / 128, q = r % 128, kb = q / 32, nb = q % 32;
        tr_item8(in20_ + (size_t)e * 256 * 1024 + (size_t)(64 * kb) * 1024 + 32 * nb, 1024, (unsigned char*)(F.ws + WS_WD) + ((size_t)e * 1024 + COL64ROW(32 * nb)) * 256 + 64 * kb, 256, D8_SCALE, scr, lane); }
}

__device__ __forceinline__ void p1_wquant(Frame& F) {
    const int lane = mk_lane(), tid = F.wave * 64 + lane; (void)tid;
    const float* const in5_ = inp(F, 5);
    LAS float* scr = (LAS float*)(F.lds + RING_OFF + F.wave * 16384);
    const int gw = F.vcu * NWAVES + F.wave, NGW = F.G * NWAVES;
    for (int r = gw; r < 16 * 160; r += NGW) { const int kb = r / 160, nb = r % 160, n0 = 32 * nb, t = n0 >> 8, rho = n0 & 255; int sc;
        const int c64 = 64 * ((rho >> 5) & 3) + 32 * (rho >> 7);
        if (t < 4) sc = rho < 128 ? 128 * t + rho : 1024 + 128 * t + (rho - 128); else if (t < 6) sc = 512 + 256 * (t - 4) + c64;
        else if (t < 10) sc = (t < 8 ? 1536 : 2048) + 256 * (t < 8 ? t - 6 : t - 8) + c64; else if (t < 12) sc = 2560 + 256 * (t - 10) + c64;
        else if (t < 16) sc = 3080 + 256 * (t - 12) + c64; else sc = 4104 + 256 * (t - 16) + c64;
        tr_item_q8(in5_ + (size_t)(64 * kb) * INC + sc, INC, (unsigned char*)(F.ws + WS_WIN8) + (size_t)n0 * 1024 + 64 * kb, 1024, (const unsigned*)(F.ctl + CW_CMAX) + n0, kb == 0 ? (float*)(F.ws + WS_CS) + n0 : nullptr, scr, lane); }
}
__device__ __forceinline__ void p3_woquant(Frame& F) {
    const int lane = mk_lane();
    LAS float* scr = (LAS float*)(F.lds + RING_OFF + F.wave * 16384);
    const int gw = F.vcu * NWAVES + F.wave, NGW = F.G * NWAVES;
    const float* const in12_ = inp(F, 12);
    for (int r = gw; r < 16 * 32; r += NGW) { const int kb = r / 32, nb = r % 32, n0 = COL64ROW(32 * nb);
        tr_item_q8(in12_ + (size_t)(64 * kb) * 1024 + 32 * nb, 1024, (unsigned char*)(F.ws + WS_WO) + (size_t)n0 * 1024 + 64 * kb, 1024, (const unsigned*)(F.ctl + CW_CMAX) + PP5 + n0, kb == 0 ? (float*)(F.ws + WS_CSO) + n0 : nullptr, scr, lane); }
}
__device__ __forceinline__ void p1_hpass(Frame& F, int panel) {
    const int lane = mk_lane(), tid = F.wave * 64 + lane; (void)tid;
    const float* const in0_ = inp(F, 0);
    const float* const in3_ = inp(F, 3);
    const float* const in4_ = inp(F, 4);
    const float* const in6_ = inp(F, 6);
    const int b = panel / PPS;
    LAS float* smod = (LAS float*)(F.lds + 0);
    constexpr int HPITCH = 2064;
    LAS unsigned char* HROW = F.lds + 8192;
    LAS float* PART = (LAS float*)(F.lds + 8192 + 32 * HPITCH);
    LAS float* LF = (LAS float*)(F.lds + 8192 + 32 * HPITCH + 8192);
    const float* MODP = (const float*)(F.ws + WS_MODP); float* MOD = (float*)(F.ws + WS_MOD);
    { const int piece = panel % PPS; const int c4a = tid; const bool ex = F.wave == 0; const int c4b = 512 + piece * 64 + (tid & 63);
      f32x4 sa = *(const f32x4*)(in3_ + 4 * c4a), sb = {0.f, 0.f, 0.f, 0.f};
      if (ex) sb = *(const f32x4*)(in3_ + 4 * c4b);
#pragma unroll
      for (int ks = 0; ks < 16; ++ks) sa += *(const f32x4*)(MODP + ((size_t)ks * 16 + b) * MODC + 4 * c4a);
      if (ex) {
#pragma unroll
          for (int ks = 0; ks < 16; ++ks) sb += *(const f32x4*)(MODP + ((size_t)ks * 16 + b) * MODC + 4 * c4b);
          *(f32x4*)(MOD + (size_t)b * MODC + 4 * c4b) = sb; }
      *(LAS f32x4*)(smod + 4 * c4a) = sa;
      if ((c4a >> 5) == piece) *(f32x4*)(MOD + (size_t)b * MODC + 4 * c4a) = sa; }
    pg8::bf16x8 bhi[4], blo[4];
    { const float* WFg = (const float*)(F.ws + WS_WF); const int n = lane & 15, g = lane >> 4;
#pragma unroll
      for (int s = 0; s < 4; ++s) { const int k0 = 128 * F.wave + 32 * s + 8 * g; f32x4 wa = {0.f, 0.f, 0.f, 0.f}, wb = wa;
          if (n < 8) { wa = *(const f32x4*)(WFg + n * 1024 + k0); wb = *(const f32x4*)(WFg + n * 1024 + k0 + 4); }
          const float w8[8] = {wa.x, wa.y, wa.z, wa.w, wb.x, wb.y, wb.z, wb.w}; unsigned hw[8], lw[8];
#pragma unroll
          for (int i = 0; i < 8; ++i) { hw[i] = f2bf(w8[i]); lw[i] = f2bf(w8[i] - __uint_as_float(hw[i] << 16)); }
          bhi[s] = __builtin_bit_cast(pg8::bf16x8, (v4u){hw[0] | (hw[1] << 16), hw[2] | (hw[3] << 16), hw[4] | (hw[5] << 16), hw[6] | (hw[7] << 16)});
          blo[s] = __builtin_bit_cast(pg8::bf16x8, (v4u){lw[0] | (lw[1] << 16), lw[2] | (lw[3] << 16), lw[4] | (lw[5] << 16), lw[6] | (lw[7] << 16)}); } }
    LDS_WAIT(); __syncthreads();
    f32x4 av[4], sh[4];
#pragma unroll
    for (int j = 0; j < 4; ++j) { const int col = 4 * lane + 256 * j; const f32x4 nw = *(const f32x4*)(in4_ + col); const f32x4 sc = *(const LAS f32x4*)(smod + 1024 + col); sh[j] = *(const LAS f32x4*)(smod + col); av[j] = nw * (sc + 1.0f); }
    const float bfg = in6_[lane & 7];
    for (int r0 = 0; r0 < 32; r0 += 4) {
      f32x4 xv[4][4];
#pragma unroll
      for (int q = 0; q < 4; ++q) { const GAS f32x4* xr = (const GAS f32x4*)(in0_ + ((size_t)panel * 256 + F.wave * 32 + r0 + q) * D) + lane;
#pragma unroll
          for (int j = 0; j < 4; ++j) xv[q][j] = __builtin_nontemporal_load(xr + 64 * j); }
#pragma unroll
      for (int q = 0; q < 4; ++q) {
        const int rl = F.wave * 32 + r0 + q; const size_t row = (size_t)panel * 256 + rl;
        float ss = 0.f;
#pragma unroll
        for (int j = 0; j < 4; ++j) { const f32x4 t = xv[q][j]; ss += (t.x * t.x + t.y * t.y) + (t.z * t.z + t.w * t.w); }
        const float rstd = 1.0f / sqrtf(wave_sum(ss) * (1.0f / D) + EPS);
        GAS unsigned* o4 = (GAS unsigned*)(F.ws + WS_H8 + row * D) + lane; float am = 0.f;
#pragma unroll
        for (int j = 0; j < 4; ++j) { const f32x4 t = xv[q][j] * rstd * av[j] + sh[j]; xv[q][j] = t; am = fmaxf(fmaxf(am, fmaxf(fabsf(t.x), fabsf(t.y))), fmaxf(fabsf(t.z), fabsf(t.w))); }
        am = wave_max(am); const float inv = am > 0.f ? 127.0f / am : 0.f;
#pragma unroll
        for (int j = 0; j < 4; ++j) { const f32x4 t = xv[q][j] * inv; o4[64 * j] = pk4_i8(t.x, t.y, t.z, t.w); }
        if (lane == 0) ((float*)(F.ws + WS_RS))[row] = am * (1.0f / 127.0f);
#pragma unroll
        for (int j = 0; j < 4; ++j) { const f32x4 t = xv[q][j]; *(LAS v2u*)(HROW + (F.wave * 4 + q) * HPITCH + 512 * j + 8 * lane) = (v2u){pg8::cvt_pk_bf16(t.x, t.y), pg8::cvt_pk_bf16(t.z, t.w)}; }
      }
      LDS_WAIT(); __syncthreads();
      { f32x4 acc0 = {0.f, 0.f, 0.f, 0.f}, acc1 = acc0;
        const LAS unsigned char* ap = HROW + (lane & 15) * HPITCH + (128 * F.wave + 8 * (lane >> 4)) * 2;
#pragma unroll
        for (int s = 0; s < 4; ++s) { const pg8::bf16x8 a0 = *(const LAS pg8::bf16x8*)(ap + 64 * s), a1 = *(const LAS pg8::bf16x8*)(ap + 16 * HPITCH + 64 * s);
            acc0 = __builtin_amdgcn_mfma_f32_16x16x32_bf16(a0, bhi[s], acc0, 0, 0, 0); acc1 = __builtin_amdgcn_mfma_f32_16x16x32_bf16(a1, bhi[s], acc1, 0, 0, 0);
            acc0 = __builtin_amdgcn_mfma_f32_16x16x32_bf16(a0, blo[s], acc0, 0, 0, 0); acc1 = __builtin_amdgcn_mfma_f32_16x16x32_bf16(a1, blo[s], acc1, 0, 0, 0); }
        if ((lane & 15) < 8) {
#pragma unroll
            for (int i = 0; i < 4; ++i) { PART[(F.wave * 32 + 4 * (lane >> 4) + i) * 8 + (lane & 15)] = acc0[i]; PART[(F.wave * 32 + 16 + 4 * (lane >> 4) + i) * 8 + (lane & 15)] = acc1[i]; } } }
      LDS_WAIT(); __syncthreads();
      if (tid < 256) { const int rho = tid >> 3; float z = bfg;
#pragma unroll
          for (int w = 0; w < 8; ++w) z += PART[(w * 32 + rho) * 8 + (tid & 7)];
          const float z2 = z * LOG2E; const int rl = (rho >> 2) * 32 + r0 + (rho & 3);
          LF[rl * 8 + (tid & 7)] = fminf(z2, 0.f) - __builtin_amdgcn_logf(1.0f + __builtin_amdgcn_exp2f(-fabsf(z2))); }
    }
    LDS_WAIT(); __syncthreads();
    {
        const int h = F.wave; const float v0 = LF[(4 * lane) * 8 + h], v1 = LF[(4 * lane + 1) * 8 + h], v2 = LF[(4 * lane + 2) * 8 + h], v3 = LF[(4 * lane + 3) * 8 + h];
        const float s0 = v0, s1 = s0 + v1, s2 = s1 + v2, s3 = s2 + v3; float inc = s3;
#pragma unroll
        for (int o = 1; o < 64; o <<= 1) { const float t = __shfl_up(inc, o); if (lane >= o) inc += t; }
        const float ex = inc - s3;
        float* FL = (float*)(F.ws + WS_FL) + ((size_t)(b * NH + h)) * SEQ + (panel % PPS) * 256 + 4 * lane;
        *(f32x4*)FL = (f32x4){ex + s0, ex + s1, ex + s2, ex + s3};
        if (lane == 63) ((float*)(F.ws + WS_PT))[panel * NH + h] = inc;
    }
    LDS_WAIT(); __syncthreads();
}

__device__ __forceinline__ void p2_router_weights(Frame& F) {
    const int lane = mk_lane();
    const float* const in13_ = inp(F, 13);
    const float* const in14_ = inp(F, 14);
    const float* const in16_ = inp(F, 16);
    const float* MOD = (const float*)(F.ws + WS_MOD);
    bf16* WRB = (bf16*)(F.ws + WS_WRB);
    const int gw = F.vcu * NWAVES + F.wave, NGW = F.G * NWAVES;
    for (int idx = gw * 64 + lane; idx < 16 * 1024; idx += NGW * 64) { const int kk = idx & 1023, b = idx >> 10;
        f32x4 wv[9]; wv[0] = *(const f32x4*)(in14_ + kk * 4);
#pragma unroll
        for (int q = 0; q < 8; ++q) wv[1 + q] = *(const f32x4*)(in16_ + kk * 32 + 4 * q);
        const float a = in13_[kk] * (1.0f + MOD[(size_t)b * MODC + 4 * D + kk]);
        bf16* dst = WRB + (size_t)b * 256 * 1024 + kk;
#pragma unroll
        for (int c = 0; c < 36; ++c) { const float w = wv[c >> 2][c & 3] * a; const unsigned hb = f2bf(w);
            dst[(size_t)c * 1024] = (bf16)hb; dst[(size_t)(40 + c) * 1024] = (bf16)f2bf(w - __uint_as_float(hb << 16)); } }
    if (gw < 16 * 36) { const int b = gw / 36, c = gw % 36; float s = 0.f;
#pragma unroll
        for (int j = 0; j < 16; ++j) { const int kk = lane + 64 * j; s += MOD[(size_t)b * MODC + 3 * D + kk] * (c < 4 ? in14_[kk * 4 + c] : in16_[kk * 32 + (c - 4)]); }
        s = wave_sum(s); if (lane == 0) ((float*)(F.ws + WS_BR))[b * 40 + c] = s; }
}

__device__ __forceinline__ void p4_conv(Frame& F, int panel) {
    const int lane = mk_lane();
    const float* const in7_ = inp(F, 7);
    bf16* PROJ = (bf16*)(F.ws + WS_PROJ);
    const float* cw = in7_ + 8 * lane;
    const f32x4 wa0 = *(const f32x4*)cw, wa1 = *(const f32x4*)(cw + 4), wb0 = *(const f32x4*)(cw + CW), wb1 = *(const f32x4*)(cw + CW + 4), wc0 = *(const f32x4*)(cw + 2 * CW), wc1 = *(const f32x4*)(cw + 2 * CW + 4);
    const size_t row0 = (size_t)panel * 256 + F.wave * 32; const int t0 = (int)(row0 % SEQ);
    const v4u z = {0u, 0u, 0u, 0u};
    v4u p1 = z, p2 = z;
    if (t0 >= 2) { const bf16* rp = PROJ + row0 * PP + PC_U + 8 * lane; p1 = *(const v4u*)(rp - PP); p2 = *(const v4u*)(rp - 2 * PP); }
    _Pragma("nounroll") for (int r0 = 0; r0 < 32; r0 += 8) {
        v4u uu[8], bb[8];
#pragma unroll
        for (int q = 0; q < 8; ++q) { const bf16* rp = PROJ + (row0 + r0 + q) * PP; uu[q] = *(const v4u*)(rp + PC_U + 8 * lane); bb[q] = *(const v4u*)(rp + PC_B + 8 * lane); }
#pragma unroll
        for (int q = 0; q < 8; ++q) {
            const v4u u0 = uu[q], u1 = q >= 1 ? uu[q - 1] : p1, u2 = q >= 2 ? uu[q - 2] : (q == 1 ? p1 : p2), bc = bb[q];
            const float s8_ = YA8_SCALE;
            v2u o;
            o.x = pk4_fp8(s8_ * (bflo(bc.x) * (wa0.x * bflo(u2.x) + wb0.x * bflo(u1.x) + wc0.x * bflo(u0.x))), s8_ * (bfhi(bc.x) * (wa0.y * bfhi(u2.x) + wb0.y * bfhi(u1.x) + wc0.y * bfhi(u0.x))), s8_ * (bflo(bc.y) * (wa0.z * bflo(u2.y) + wb0.z * bflo(u1.y) + wc0.z * bflo(u0.y))), s8_ * (bfhi(bc.y) * (wa0.w * bfhi(u2.y) + wb0.w * bfhi(u1.y) + wc0.w * bfhi(u0.y))));
            o.y = pk4_fp8(s8_ * (bflo(bc.z) * (wa1.x * bflo(u2.z) + wb1.x * bflo(u1.z) + wc1.x * bflo(u0.z))), s8_ * (bfhi(bc.z) * (wa1.y * bfhi(u2.z) + wb1.y * bfhi(u1.z) + wc1.y * bfhi(u0.z))), s8_ * (bflo(bc.w) * (wa1.z * bflo(u2.w) + wb1.z * bflo(u1.w) + wc1.z * bflo(u0.w))), s8_ * (bfhi(bc.w) * (wa1.w * bfhi(u2.w) + wb1.w * bfhi(u1.w) + wc1.w * bfhi(u0.w))));
            *(v2u*)((unsigned char*)(PROJ + (row0 + r0 + q) * PP + PC_C) + 8 * lane) = o; }
        p2 = uu[6]; p1 = uu[7];
    }
}

__device__ __forceinline__ void p5_h2pass(Frame& F, int panel) {
    const int lane = mk_lane(), tid = F.wave * 64 + lane; (void)tid;
    const float* const in13_ = inp(F, 13);
    const int b = panel / PPS; const float* MOD = (const float*)(F.ws + WS_MOD) + (size_t)b * MODC;
    f32x4 av[4], sh[4];
#pragma unroll
    for (int j = 0; j < 4; ++j) { const int col = 4 * lane + 256 * j; const f32x4 nw = *(const f32x4*)(in13_ + col); const f32x4 sc = *(const f32x4*)(MOD + 4 * D + col); sh[j] = *(const f32x4*)(MOD + 3 * D + col); av[j] = nw * (sc + 1.0f); }
    for (int r0 = 0; r0 < 32; r0 += 4) {
        const size_t rowb = (size_t)panel * 256 + F.wave * 32 + r0;
        v2u dv[4][4];
#pragma unroll
        for (int q = 0; q < 4; ++q) { const GAS v2u* dr = (const GAS v2u*)((const bf16*)(F.ws + WS_DELTA) + (rowb + q) * D) + lane;
#pragma unroll
            for (int j = 0; j < 4; ++j) dv[q][j] = dr[64 * j]; }
#pragma unroll
        for (int q = 0; q < 4; ++q) { const size_t row = rowb + q;
            f32x4 v[4]; float ss = 0.f;
#pragma unroll
            for (int j = 0; j < 4; ++j) { const v2u dd = dv[q][j]; v[j] = (f32x4){bflo(dd.x), bfhi(dd.x), bflo(dd.y), bfhi(dd.y)}; ss += (v[j].x * v[j].x + v[j].y * v[j].y) + (v[j].z * v[j].z + v[j].w * v[j].w); }
            const float rstd = 1.0f / sqrtf(wave_sum(ss) * (1.0f / D) + EPS);
            if (lane == 0) ((LAS float*)(F.lds + pg8::NA_LDS_OFF))[F.wave * 32 + r0 + q] = rstd;
#pragma unroll
            for (int j = 0; j < 4; ++j) v[j] = v[j] * rstd * av[j] + sh[j];
            GAS unsigned* o4 = (GAS unsigned*)(F.ws + WS_H8 + row * D) + lane;
#pragma unroll
            for (int j = 0; j < 4; ++j) __builtin_nontemporal_store(pk4_fp8(v[j].x, v[j].y, v[j].z, v[j].w), o4 + 64 * j); }
    }
}
__device__ __forceinline__ void p5_route(Frame& F, int panel) {
    const int lane = mk_lane(), tid = F.wave * 64 + lane; (void)tid;
    const float* const in15_ = inp(F, 15);
    const float* const in17_ = inp(F, 17);
    LAS int* lcnt = (LAS int*)(F.lds + TAB_OFF + 512); LAS int* gbase = (LAS int*)(F.lds + TAB_OFF + 768);
    if (tid < 32) lcnt[tid] = 0;
    LDS_WAIT(); __syncthreads();
    int e1 = 0, e2 = 0, r1 = 0, r2 = 0; float w1 = 0.f, w2 = 0.f; const int row = panel * 256 + tid;
    if (tid < 256) {
        const float* lg = (const float*)(F.ws + WS_LOG) + (size_t)row * NLOG;
        float g[4];
        const float* br = (const float*)(F.ws + WS_BR) + (panel / PPS) * 40;
#pragma unroll
        for (int k = 0; k < 4; ++k) g[k] = lg[k] + lg[40 + k] + in15_[k] + br[k];
        int gi = 0; float best = g[0];
#pragma unroll
        for (int k = 1; k < 4; ++k) if (g[k] > best) { best = g[k]; gi = k; }
        float den = 0.f;
#pragma unroll
        for (int k = 0; k < 4; ++k) den += expf(g[k] - best);
        const float psel = 1.0f / den;
        float le[8];
#pragma unroll
        for (int j = 0; j < 8; ++j) le[j] = lg[4 + 8 * gi + j] + lg[44 + 8 * gi + j] + in17_[8 * gi + j] + br[4 + 8 * gi + j];
        int i1 = 0; float v1 = le[0];
#pragma unroll
        for (int j = 1; j < 8; ++j) if (le[j] > v1) { v1 = le[j]; i1 = j; }
        int i2 = -1; float v2 = -INFINITY;
#pragma unroll
        for (int j = 0; j < 8; ++j) if (j != i1 && (i2 < 0 || le[j] > v2)) { v2 = le[j]; i2 = j; }
        const float s = expf(v2 - v1); w1 = psel / (1.0f + s); w2 = psel * s / (1.0f + s);
        e1 = 8 * gi + i1; e2 = 8 * gi + i2;
        r1 = __hip_atomic_fetch_add(lcnt + e1, 1, __ATOMIC_RELAXED, __HIP_MEMORY_SCOPE_WORKGROUP);
        r2 = __hip_atomic_fetch_add(lcnt + e2, 1, __ATOMIC_RELAXED, __HIP_MEMORY_SCOPE_WORKGROUP);
    }
    LDS_WAIT(); __syncthreads();
    if (tid < 32) { const int n = lcnt[tid]; gbase[tid] = n > 0 ? (int)__hip_atomic_fetch_add((unsigned*)(F.ctl + CW_CNT + tid), (unsigned)n, RLX_AGENT) : 0; }
    LDS_WAIT(); __syncthreads();
    if (tid < 256) {
        const int p1 = gbase[e1] + r1, p2 = gbase[e2] + r2;
        int* LIST = (int*)(F.ws + WS_LIST); float* WL = (float*)(F.ws + WS_WLIST);
        LIST[(size_t)e1 * LISTCAP + p1] = row; WL[(size_t)e1 * LISTCAP + p1] = w1;
        LIST[(size_t)e2 * LISTCAP + p2] = row; WL[(size_t)e2 * LISTCAP + p2] = w2;
        ((int*)(F.ws + WS_POS))[2 * row] = (e1 << 17) | p1; ((int*)(F.ws + WS_POS))[2 * row + 1] = (e2 << 17) | p2;
    }
}
__device__ __forceinline__ void moe_tables(Frame& F) {
    const int lane = mk_lane(), tid = F.wave * 64 + lane; (void)tid;
    LAS int* tab = (LAS int*)(F.lds + TAB_OFF);
    if (tid == 0) { int acc = 0;
#pragma unroll
        for (int e = 0; e < NE; ++e) { int n = (int)__hip_atomic_load((unsigned*)(F.ctl + CW_CNT + e), RLX_AGENT); if (n > LISTCAP) n = LISTCAP; tab[e] = acc; tab[64 + e] = n; acc += (n + 255) >> 8; }
        tab[32] = acc; }
    LDS_WAIT(); __syncthreads();
    const int ttot = tab[32];
    for (int T = tid; T < ttot && T < 1024; T += NWAVES * 64) { int e = 0;
#pragma unroll 4
        for (int j = 1; j < NE; ++j) e += (T >= tab[j]) ? 1 : 0;
        tab[256 + T] = e; }
    LDS_WAIT(); __syncthreads();
}
__device__ __forceinline__ void p8_combine(Frame& F) {
    const int lane = mk_lane(), tid = F.wave * 64 + lane; (void)tid;
    const LAS int* tab = (const LAS int*)(F.lds + TAB_OFF);
    const unsigned char* Y = (const unsigned char*)(F.ws + WS_Y); const int* POS = (const int*)(F.ws + WS_POS); const float* MOD = (const float*)(F.ws + WS_MOD);
    typedef float f32x2c __attribute__((ext_vector_type(2)));
    const int gw = F.vcu * NWAVES + F.wave, NGW = F.G * NWAVES, RPW = M / NGW;
    const int row0 = gw * RPW, b = row0 / SEQ;
    f32x4 g2[4];
#pragma unroll
    for (int q = 0; q < 4; ++q) g2[q] = *(const f32x4*)(MOD + (size_t)b * MODC + 5 * D + 4 * lane + 256 * q) * (1.0f / Y8_SCALE);
    for (int r0 = 0; r0 < RPW; r0 += 2) {
        unsigned y1[2][4], y2[2][4]; v2u xs[2][4];
#pragma unroll
        for (int u = 0; u < 2; ++u) { const int row = row0 + r0 + u; const int k1 = POS[2 * row], k2 = POS[2 * row + 1];
            const size_t q1 = (size_t)tab[k1 >> 17] * 256 + (k1 & 0x1ffff), q2 = (size_t)tab[k2 >> 17] * 256 + (k2 & 0x1ffff);
            const GAS unsigned* p1 = (const GAS unsigned*)(Y + q1 * 1024) + lane; const GAS unsigned* p2 = (const GAS unsigned*)(Y + q2 * 1024) + lane;
            const GAS v2u* px = (const GAS v2u*)((const bf16*)(F.ws + WS_DELTA) + (size_t)row * D) + lane;
#pragma unroll
            for (int q = 0; q < 4; ++q) { y1[u][q] = p1[64 * q]; y2[u][q] = p2[64 * q]; xs[u][q] = __builtin_nontemporal_load(px + 64 * q); } }
#pragma unroll
        for (int u = 0; u < 2; ++u) { GAS f32x4* po = (GAS f32x4*)(F.out + (size_t)(row0 + r0 + u) * D) + lane;
#pragma unroll
            for (int q = 0; q < 4; ++q) { const unsigned a = y1[u][q], c = y2[u][q];
                const f32x2c a0 = __builtin_amdgcn_cvt_pk_f32_fp8((int)a, false), a1 = __builtin_amdgcn_cvt_pk_f32_fp8((int)a, true), c0 = __builtin_amdgcn_cvt_pk_f32_fp8((int)c, false), c1 = __builtin_amdgcn_cvt_pk_f32_fp8((int)c, true);
                const v2u dd = xs[u][q]; const f32x4 g = g2[q]; f32x4 x = (f32x4){bflo(dd.x), bfhi(dd.x), bflo(dd.y), bfhi(dd.y)};
                x.x += g.x * (a0.x + c0.x); x.y += g.y * (a0.y + c0.y); x.z += g.z * (a1.x + c1.x); x.w += g.w * (a1.y + c1.y);
                __builtin_nontemporal_store(x, po + 64 * q); } }
    }
}

struct Args { const float* in[21]; float* out; unsigned char* ws; int ph_lo, ph_hi, li, pad; };
__global__ void __launch_bounds__(NWAVES * 64, 2) mk_fwd(Args args) {
    extern __shared__ __attribute__((aligned(16))) unsigned char lds[];
    Frame F;
    F.lds = (LAS unsigned char*)lds;
    F.MISC = (volatile LAS unsigned*)(F.lds + MISC_OFF);
    F.wave = __builtin_amdgcn_readfirstlane((int)threadIdx.x >> 6);
    F.G = gridDim.x; { const int bx = blockIdx.x; F.vcu = (F.G % 8 == 0) ? (bx % 8) * (F.G / 8) + bx / 8 : bx; }
    unsigned char* ws = args.ws; F.ws = ws; F.out = args.out;
    F.ctl = (gu32*)(ws + WS_CTL);
    for (int u = threadIdx.x; u < (LDS_BYTES - LDSCTL_OFF) / 4; u += NWAVES * 64) ((LAS unsigned*)(F.lds + LDSCTL_OFF))[u] = 0u;
    __syncthreads();
    F.ptab = (const LAS unsigned long long*)(F.lds + PTR_OFF);
    if (threadIdx.x == 0) { LAS unsigned long long* pt = (LAS unsigned long long*)(F.lds + PTR_OFF);
        pt[0] = (unsigned long long)args.in[0];
        pt[1] = (unsigned long long)args.in[1];
        pt[2] = (unsigned long long)args.in[2];
        pt[3] = (unsigned long long)args.in[3];
        pt[4] = (unsigned long long)args.in[4];
        pt[5] = (unsigned long long)args.in[5];
        pt[6] = (unsigned long long)args.in[6];
        pt[7] = (unsigned long long)args.in[7];
        pt[8] = (unsigned long long)args.in[8];
        pt[9] = (unsigned long long)args.in[9];
        pt[10] = (unsigned long long)args.in[10];
        pt[11] = (unsigned long long)args.in[11];
        pt[12] = (unsigned long long)args.in[12];
        pt[13] = (unsigned long long)args.in[13];
        pt[14] = (unsigned long long)args.in[14];
        pt[15] = (unsigned long long)args.in[15];
        pt[16] = (unsigned long long)args.in[16];
        pt[17] = (unsigned long long)args.in[17];
        pt[18] = (unsigned long long)args.in[18];
        pt[19] = (unsigned long long)args.in[19];
        pt[20] = (unsigned long long)args.in[20];
    }
    __syncthreads();
    XcdBarrier bar; bar.bar = (unsigned*)(F.ctl + CW_BAR); bar.x = 0; bar.st = nullptr;
    if (N_LAUNCHES == 1) bar = xcd_barrier_post((unsigned*)(F.ctl + CW_BAR), F.MISC + 8, threadIdx.x == 0);
#define GRID_BAR() do { if (N_LAUNCHES == 1) xcd_barrier(bar, F.wave == 0 && mk_lane() == 0); } while (0)
#define WG_SYNC() do { VM_WAIT(); __syncthreads(); } while (0)
    const int lo = args.ph_lo, hi = args.ph_hi;
#ifndef REP_P9
#define REP_P9 1
#endif
#ifndef REP_H2
#define REP_H2 1
#endif
#ifndef REP_WQ
#define REP_WQ 1
#endif
#ifndef REP_P0
#define REP_P0 1
#endif
#ifndef REP_P1
#define REP_P1 1
#endif
#ifndef REP_P2
#define REP_P2 1
#endif
#ifndef REP_CONV
#define REP_CONV 1
#endif
#ifndef REP_G12
#define REP_G12 1
#endif
#ifndef REP_G3
#define REP_G3 1
#endif
#ifndef REP_P6
#define REP_P6 1
#endif
#ifndef REP_P7
#define REP_P7 1
#endif
#ifndef P2_MASK
#define P2_MASK 3
#endif
#ifndef P5_MASK
#define P5_MASK 0x3f
#endif
#ifndef PHASE_MASK
#define PHASE_MASK 0x3ff
#endif
#define IN(k) ((((PHASE_MASK) >> (k)) & 1) && lo <= (k) && (k) < hi)
#define BOTH(k) (IN(k) && IN((k) + 1))
    const int panel = F.vcu;
    bf16* const H = (bf16*)(ws + WS_H); bf16* const PROJ = (bf16*)(ws + WS_PROJ);

    if (IN(0)) { _Pragma("nounroll") for (int rep = 0; rep < REP_P0; ++rep) p0_prologue(F); if (BOTH(0)) GRID_BAR(); }
    if (IN(1)) { _Pragma("nounroll") for (int rep = 0; rep < REP_WQ; ++rep) p1_wquant(F); LDS_WAIT(); __syncthreads(); _Pragma("nounroll") for (int rep = 0; rep < REP_P1; ++rep) if (panel < NPANEL) p1_hpass(F, panel); if (BOTH(1)) GRID_BAR(); }
#ifndef STAG2
#define STAG2 0
#endif
#ifndef STAG5
#define STAG5 0
#endif
#define XCD_STAGGER(n) do { if (blockIdx.x & 1) { _Pragma("unroll") for (int s_ = 0; s_ < (n); ++s_) __builtin_amdgcn_s_sleep(127); } } while (0)
    if (IN(2)) {
        XCD_STAGGER(STAG2);
        {
            pg8::DenseStatic S; S.A = (const char*)(ws + WS_H8); S.Bt = (const char*)(ws + WS_WIN8); S.a_tstep = (size_t)256 * D; S.b_tstep = (size_t)256 * D; S.so.init(M, PP5, F.G, (int)blockIdx.x);
            pg8::EpiInProj E{PROJ, (bf16*)(ws + WS_KB), (bf16*)(ws + WS_VB), inp(F, 8), inp(F, 9), (const float*)(ws + WS_RS), (const float*)(ws + WS_CS), F.lds + OST_OFF, F.lds + pg8::NA_LDS_OFF};
            _Pragma("nounroll") for (int rep = 0; rep < REP_P2; ++rep) pg8::gemm_phase<pg8::EpiInProj, pg8::DenseStatic, false, true, false, true>(F.lds + RING_OFF, F.wave, D, D, S, E); }
        if (BOTH(2)) GRID_BAR();
    }
    if (IN(3)) {
#ifndef CONV_TICKETS
#define CONV_TICKETS 1
#endif
        const bool conv_first = !CONV_TICKETS;
        p2_router_weights(F);
        p3_woquant(F); LDS_WAIT(); __syncthreads();
        if (conv_first && panel < NPANEL) p4_conv(F, panel);
        static_assert(attn_body::ATTN_LDS_BYTES <= RING_BYTES && attn_body::ATTN_PITCH == PP, "attention body geometry vs frame");
        float prune, zref; int nomax;
        { const int l_ = mk_lane(); const float bq = wave_max(fabsf(inp(F, 8)[l_])), bk = wave_max(fabsf(inp(F, 9)[l_])); prune = __builtin_bit_cast(float, __builtin_amdgcn_readfirstlane(__builtin_bit_cast(int, -(37.5f + 2.0f * 11.6f * bq * bk))));
          nomax = __builtin_amdgcn_readfirstlane(11.6f * bq * bk < 60.0f ? 1 : 0);
          zref = __builtin_bit_cast(float, __builtin_amdgcn_readfirstlane(__builtin_bit_cast(int, -(90.0f - 11.6f * bq * bk)))); }
        const attn_body::AttnTensors AT{(const attn_body::bf16*)(PROJ + PC_Q), (const attn_body::bf16*)(ws + WS_KB), (const attn_body::bf16*)(ws + WS_VB), (unsigned char*)(PROJ + PC_C) + 512,
                                        (const float*)(ws + WS_FL), (const float*)(ws + WS_PT), prune, nomax, zref};
#if CONV_TICKETS
        {
            const attn_body::DynOrderConv S{(unsigned*)(F.ctl + CW_ATTQ), F.MISC + 16, F.wave};
            attn_body::AttnUnit u; unsigned pre; S.prime(pre);
            if (AT.nomax) { for (int i = 0; S.next(i, u, pre); ++i) { if (u.qb < 0) p4_conv(F, u.bh); else attn_body::attn_unit<8, true>(u.bh / attn_body::NHEAD, u.bh % attn_body::NHEAD, u.qb, AT.Q, AT.K, AT.V, AT.O, AT.FL, AT.PT, AT.prune, AT.zref, (char*)lds + RING_OFF, F.wave); } }
            else { for (int i = 0; S.next(i, u, pre); ++i) { if (u.qb < 0) p4_conv(F, u.bh); else attn_body::attn_unit<8, false>(u.bh / attn_body::NHEAD, u.bh % attn_body::NHEAD, u.qb, AT.Q, AT.K, AT.V, AT.O, AT.FL, AT.PT, AT.prune, AT.zref, (char*)lds + RING_OFF, F.wave); } }
        }
#else
        const attn_body::DynOrder S{(unsigned*)(F.ctl + CW_ATTQ), F.MISC + 16, F.wave};
        attn_body::attn_phase<attn_body::DynOrder>((char*)lds + RING_OFF, AT, S, F.wave);
#endif
        if (BOTH(3)) GRID_BAR();
    }
#ifndef STAG4
#define STAG4 0
#endif
    if (IN(4)) {
        XCD_STAGGER(STAG4);
        { const int ne_ = (0x4310 >> (4 * (blockIdx.x & 3))) & 15;
          const int base_ = (F.vcu * NWAVES + F.wave) * 4;
          for (int k_ = 0; k_ < ne_; ++k_) wgu_item(F, base_ + k_);
          LDS_WAIT(); __syncthreads(); }
        pg8::OwnPanelRot S{(const char*)(PROJ + PC_C), (const char*)(ws + WS_WOC), (size_t)256 * PP * 2, (size_t)256 * D, panel, 4};
#if defined(PROBE_P4_NULL)
        { pg8::EpiNull EN; pg8::gemm_phase<pg8::EpiNull, pg8::DenseStatic, false, true>(F.lds + RING_OFF, F.wave, PP, D, S, EN); }
#endif
        pg8::EpiMerge E{PROJ, (unsigned char*)H, (signed char*)(ws + WS_EX), F.lds + OST_OFF, F.lds + pg8::NA_LDS_OFF};
        pg8::gemm_phase<pg8::EpiMerge, pg8::OwnPanelRot, false, true, true>(F.lds + RING_OFF, F.wave, PP * 2, D, S, E);
        if (BOTH(4)) { WG_SYNC(); __builtin_amdgcn_fence(__ATOMIC_ACQUIRE, "agent"); }
    }
    if (IN(5)) {
        XCD_STAGGER(STAG5);
        pg8::OwnPanelRot S{(const char*)H, (const char*)(ws + WS_WO), (size_t)256 * D, (size_t)256 * D, panel, 4};
        pg8::EpiDelta8 E{(const float*)(ws + WS_MOD), inp(F, 0), (bf16*)(ws + WS_DELTA), (const signed char*)(ws + WS_EX), (const float*)(ws + WS_CSO), F.lds + OST_OFF};
        pg8::gemm_phase<pg8::EpiDelta8, pg8::OwnPanelRot, false, true, false, true>(F.lds + RING_OFF, F.wave, D, D, S, E);
        if (BOTH(5)) { WG_SYNC(); __builtin_amdgcn_fence(__ATOMIC_ACQUIRE, "agent"); }
    }
    if (IN(6)) {
        if (panel < NPANEL) {
            _Pragma("nounroll") for (int rep = 0; rep < REP_H2; ++rep) p5_h2pass(F, panel);
            WG_SYNC();
            { pg8::OwnPanel S{(const char*)(ws + WS_DELTA), (const char*)(ws + WS_WRB + (size_t)(panel / PPS) * 256 * D * 2), (size_t)256 * D * 2, (size_t)256 * D * 2, panel, 1};
              pg8::EpiLogits E{(float*)(ws + WS_LOG), NLOG, NLOG, (const LAS float*)(F.lds + pg8::NA_LDS_OFF)};
              pg8::gemm_phase<pg8::EpiLogits, pg8::OwnPanel, false, false, false, false, true>(F.lds + RING_OFF, F.wave, D, D, S, E); }
            WG_SYNC();
            p5_route(F, panel);
        }
        { const int ne_ = (0x4310 >> (4 * (blockIdx.x & 3))) & 15; const int base_ = (F.vcu * NWAVES + F.wave) * 4;
          LDS_WAIT(); __syncthreads();
          for (int k_ = ne_; k_ < 4; ++k_) wgu_item(F, base_ + k_); }
        if (BOTH(6)) GRID_BAR();
    }
    if (IN(7)) {
        moe_tables(F);
        typedef pg8::MoeSched<2, 0, (size_t)512 * D, (size_t)256 * D> Sched7;
        Sched7 S{(const char*)(ws + WS_H8), (const char*)(ws + WS_WGU), (const int*)(ws + WS_LIST), (const LAS int*)(F.lds + TAB_OFF), F.G, F.vcu};
        pg8::EpiGLU E{(unsigned char*)(ws + WS_ACT), (const float*)(ws + WS_WLIST), 1.0f / W8_SCALE, F.lds + OST_OFF};
        _Pragma("nounroll") for (int rep = 0; rep < REP_P6; ++rep) pg8::gemm_phase<pg8::EpiGLU, Sched7, true, true, true>(F.lds + RING_OFF, F.wave, D, D, S, E);
        p7_wd_items(F);
        if (BOTH(7)) GRID_BAR();
    }
    if (IN(8)) {
        if (!(IN(7))) moe_tables(F);
        typedef pg8::MoeSched<4, (size_t)256 * DE, (size_t)D * DE, (size_t)256 * DE> Sched8;
        Sched8 S{(const char*)(ws + WS_ACT), (const char*)(ws + WS_WD), (const int*)(ws + WS_LIST), (const LAS int*)(F.lds + TAB_OFF), F.G, F.vcu};
        pg8::EpiFp8Plain E{(unsigned char*)(ws + WS_Y), D, Y8_SCALE / (A8_SCALE * D8_SCALE), F.lds + OST_OFF};
        _Pragma("nounroll") for (int rep = 0; rep < REP_P7; ++rep) pg8::gemm_phase<pg8::EpiFp8Plain, Sched8, false, true, true>(F.lds + RING_OFF, F.wave, DE, DE, S, E);
        if (BOTH(8)) GRID_BAR();
    }
    if (IN(9)) { if (!(IN(7)) && !(IN(8))) moe_tables(F); _Pragma("nounroll") for (int rep = 0; rep < REP_P9; ++rep) p8_combine(F); }
#undef IN
#undef BOTH
}

extern "C" void kernel_launch(void* const* d_in, const int* in_sizes, int n_in, void* d_out, int out_size, void* d_ws, size_t ws_size, hipStream_t stream) {
    static int grid = 0;
    if (grid == 0) {
        if (n_in != 21 || in_sizes[0] != M * D || out_size != M * D || ws_size < WS_END) { fprintf(stderr, "kernel_launch: unexpected shapes (n_in %d, in0 %d, out %d, ws %zu); nothing launched\n", n_in, n_in > 0 ? in_sizes[0] : -1, out_size, ws_size); grid = -1; return; }
        if (hipFuncSetAttribute((const void*)mk_fwd, hipFuncAttributeMaxDynamicSharedMemorySize, LDS_BYTES) != hipSuccess) { fprintf(stderr, "kernel_launch: hipFuncSetAttribute failed\n"); grid = -1; return; }
        int per_cu = 0;
        if (hipOccupancyMaxActiveBlocksPerMultiprocessor(&per_cu, (const void*)mk_fwd, NWAVES * 64, LDS_BYTES) != hipSuccess || per_cu < 1) fprintf(stderr, "kernel_launch: note: occupancy query reports %d\n", per_cu);
        (void)hipGetLastError();
        grid = 256;
    }
    if (grid < 0) return;
    if (hipMemsetAsync((char*)d_ws + WS_CTL, 0, CTL_ZERO_BYTES, stream) != hipSuccess) { fprintf(stderr, "kernel_launch: hipMemsetAsync failed\n"); return; }
    Args a{};
    for (int i = 0; i < 21; ++i) a.in[i] = (const float*)d_in[i];
    a.out = (float*)d_out; a.ws = (unsigned char*)d_ws;
    for (int li = 0; li < N_LAUNCHES; ++li) {
        if (N_LAUNCHES == 1) { a.ph_lo = 0; a.ph_hi = N_PHASES; } else { a.ph_lo = li; a.ph_hi = li + 1; }
        a.li = li;
        hipLaunchKernelGGL(mk_fwd, dim3(grid), dim3(NWAVES * 64), LDS_BYTES, stream, a);
        const hipError_t le = hipPeekAtLastError();
        if (le != hipSuccess) { fprintf(stderr, "kernel_launch: launch %d failed: %s\n", li, hipGetErrorName(le)); break; }
    }
}
```
